# Optimizing an MI355X kernel written in HIP

```python
import math
import jax, jax.numpy as jnp
from jax import lax
import numpy as np

D_MODEL = 1024
BATCH = 4
SEQ = 4096
DEPTH = 1

N_META = 16
CONV_W = D_MODEL // 2
CONV_GROUPS = 8
LRU_W = D_MODEL // 2
LRU_HEADS = 8
D_MIX = CONV_W + LRU_W
D_IN = 2 * CONV_W + 2 * LRU_W
CONV_K = 31
LRU_CONV_K = 4
RG_C = 8.0
N_EXPERTS = 32
TOP_K = 4
D_EXPERT = D_MODEL
SWIGLU_ALPHA = 1.702
SWIGLU_LIMIT = 7.0
NORM_EPS = 1e-6
LN_EPS = 1e-5

kernel_name = "hymba_conformer_rglru_moe_block"


def rms_norm(x, g):
    x32 = x.astype(jnp.float32)
    y = x32 * lax.rsqrt(jnp.mean(x32 * x32, axis=-1, keepdims=True) + NORM_EPS)
    return (y * g.astype(jnp.float32)).astype(x.dtype)


def layer_norm(x, g, b):
    x32 = x.astype(jnp.float32)
    mu = jnp.mean(x32, axis=-1, keepdims=True)
    xc = x32 - mu
    y = xc * lax.rsqrt(jnp.mean(xc * xc, axis=-1, keepdims=True) + LN_EPS)
    return (y * g.astype(jnp.float32) + b.astype(jnp.float32)).astype(x.dtype)


def causal_depthwise_conv(x, w, b):
    k = w.shape[0]
    xp = jnp.pad(x, ((0, 0), (k - 1, 0), (0, 0)))
    y = lax.conv_general_dilated(
        xp, w[:, None, :].astype(x.dtype), window_strides=(1,), padding="VALID",
        dimension_numbers=("NWC", "WIO", "NWC"), feature_group_count=x.shape[-1])
    return y + b.astype(x.dtype)


def conformer_conv_group(val, gate, dw_w, dw_b, ln_g, ln_b):
    u = val * jax.nn.sigmoid(gate)
    u = causal_depthwise_conv(u, dw_w, dw_b)
    u = layer_norm(u, ln_g, ln_b)
    return jax.nn.silu(u)


def _lru_combine(left, right):
    a1, b1 = left
    a2, b2 = right
    return a1 * a2, a2 * b1 + b2


def rg_lru(x, w_a, b_a, w_x, b_x, lam):
    bsz, t, c = x.shape
    xh = x.reshape(bsz, t, LRU_HEADS, c // LRU_HEADS)
    r = jax.nn.sigmoid(jnp.einsum("bthi,hij->bthj", xh, w_a).reshape(bsz, t, c) + b_a)
    i = jax.nn.sigmoid(jnp.einsum("bthi,hij->bthj", xh, w_x).reshape(bsz, t, c) + b_x)
    r32 = r.astype(jnp.float32)
    log_a = -RG_C * r32 * jax.nn.softplus(-lam.astype(jnp.float32))
    a = jnp.exp(log_a)
    mult = jnp.sqrt(-jnp.expm1(2.0 * log_a))
    is_start = (jnp.arange(t) == 0)[None, :, None]
    mult = jnp.where(is_start, 1.0, mult)
    bterm = mult * (i.astype(jnp.float32) * x.astype(jnp.float32))
    _, h = lax.associative_scan(_lru_combine, (a, bterm), axis=1)
    return h.astype(x.dtype)


def griffin_group(xin, gin, conv_w, conv_b, w_a, b_a, w_x, b_x, lam):
    y = jax.nn.gelu(gin, approximate=True)
    u = causal_depthwise_conv(xin, conv_w, conv_b)
    u = rg_lru(u, w_a, b_a, w_x, b_x, lam)
    return u * y


def moe_ffn(u, w_router, b_router, w_gu, b_gu, w_down, b_down):
    bsz, t, d = u.shape
    tok = u.reshape(bsz * t, d)
    logits = (tok @ w_router + b_router).astype(jnp.float32)
    vals, idx = lax.top_k(logits, TOP_K)
    wts = jax.nn.softmax(vals, axis=-1)
    gates = jnp.einsum("nk,nke->ne", wts, jax.nn.one_hot(idx, N_EXPERTS, dtype=jnp.float32))
    gates = gates.astype(tok.dtype)

    def expert_step(acc, xs):
        wgu, bgu, wd, bd, g = xs
        hgu = tok @ wgu + bgu
        x_glu = jnp.minimum(hgu[:, 0::2], SWIGLU_LIMIT)
        x_lin = jnp.clip(hgu[:, 1::2], -SWIGLU_LIMIT, SWIGLU_LIMIT)
        act = x_glu * jax.nn.sigmoid(SWIGLU_ALPHA * x_glu) * (x_lin + 1.0)
        out = act @ wd + bd
        return acc + g[:, None] * out, None

    acc, _ = lax.scan(expert_step, jnp.zeros_like(tok), (w_gu, b_gu, w_down, b_down, gates.T))
    return acc.reshape(bsz, t, d)


def setup_inputs(seed: int = 0) -> dict:
    key = jax.random.key(seed)
    ks = jax.random.split(key, 24)
    f32 = jnp.float32
    L = DEPTH
    nrm = lambda k, shape, fan_in: jax.random.normal(k, shape, f32) * (fan_in ** -0.5)
    small = lambda k, shape, s=0.02: jax.random.normal(k, shape, f32) * s
    blk = LRU_W // LRU_HEADS
    u = jax.random.uniform(ks[14], (L, LRU_W), f32, 0.9, 0.999)
    a0 = u ** (1.0 / RG_C)
    lam = jnp.log(a0) - jnp.log1p(-a0)
    return {
        "x": jax.random.normal(ks[0], (BATCH, SEQ, D_MODEL), f32),
        "meta_tokens": jax.random.normal(ks[1], (N_META, D_MODEL), f32),
        "g_mix": 1.0 + small(ks[2], (L, D_MODEL)),
        "w_in": nrm(ks[3], (L, D_MODEL, D_IN), D_MODEL),
        "conv_dw_w": nrm(ks[4], (L, CONV_K, CONV_W), CONV_K),
        "conv_dw_b": small(ks[5], (L, CONV_W)),
        "conv_ln_g": 1.0 + small(ks[6], (L, CONV_W)),
        "conv_ln_b": small(ks[7], (L, CONV_W)),
        "lru_conv_w": nrm(ks[8], (L, LRU_CONV_K, LRU_W), LRU_CONV_K),
        "lru_conv_b": small(ks[9], (L, LRU_W)),
        "lru_wa": nrm(ks[10], (L, LRU_HEADS, blk, blk), blk),
        "lru_ba": small(ks[11], (L, LRU_W)),
        "lru_wx": nrm(ks[12], (L, LRU_HEADS, blk, blk), blk),
        "lru_bx": small(ks[13], (L, LRU_W)),
        "lru_lambda": lam,
        "w_out": nrm(ks[15], (L, D_MIX, D_MODEL), D_MIX),
        "g_ffn": 1.0 + small(ks[16], (L, D_MODEL)),
        "w_router": nrm(ks[17], (L, D_MODEL, N_EXPERTS), D_MODEL),
        "b_router": small(ks[18], (L, N_EXPERTS), 0.01),
        "w_gate_up": nrm(ks[19], (L, N_EXPERTS, D_MODEL, 2 * D_EXPERT), D_MODEL),
        "b_gate_up": small(ks[20], (L, N_EXPERTS, 2 * D_EXPERT)),
        "w_down": nrm(ks[21], (L, N_EXPERTS, D_EXPERT, D_MODEL), D_EXPERT),
        "b_down": small(ks[22], (L, N_EXPERTS, D_MODEL)),
        "g_final": 1.0 + small(ks[23], (D_MODEL,)),
    }


def reference(x, meta_tokens, g_mix, w_in, conv_dw_w, conv_dw_b, conv_ln_g, conv_ln_b,
              lru_conv_w, lru_conv_b, lru_wa, lru_ba, lru_wx, lru_bx, lru_lambda, w_out,
              g_ffn, w_router, b_router, w_gate_up, b_gate_up, w_down, b_down, g_final):
    bsz = x.shape[0]
    meta = jnp.broadcast_to(meta_tokens[None].astype(x.dtype), (bsz, N_META, D_MODEL))
    h = jnp.concatenate([meta, x], axis=1)
    for l in range(DEPTH):
        u = rms_norm(h, g_mix[l])
        z = u @ w_in[l]
        c_val, c_gate, r_x, r_gate = jnp.split(
            z, [CONV_W, 2 * CONV_W, 2 * CONV_W + LRU_W], axis=-1)
        conv_out = conformer_conv_group(c_val, c_gate, conv_dw_w[l], conv_dw_b[l],
                                        conv_ln_g[l], conv_ln_b[l])
        lru_out = griffin_group(r_x, r_gate, lru_conv_w[l], lru_conv_b[l], lru_wa[l], lru_ba[l],
                                lru_wx[l], lru_bx[l], lru_lambda[l])
        mix = jnp.concatenate([conv_out, lru_out], axis=-1)
        h = h + mix @ w_out[l]
        u = rms_norm(h, g_ffn[l])
        h = h + moe_ffn(u, w_router[l], b_router[l], w_gate_up[l], b_gate_up[l],
                        w_down[l], b_down[l])
    h = rms_norm(h, g_final)
    return h[:, N_META:]
```

```cpp
#include <hip/hip_runtime.h>
#include <stdint.h>
#include <stdio.h>

#ifndef MK_N_LAUNCHES
#define MK_N_LAUNCHES 1
#endif
#ifndef PH_MASK
#define PH_MASK 0x3ff
#endif
#ifndef REP_MASK
#define REP_MASK 0
#endif
#ifndef DBL_MASK
#define DBL_MASK 0
#endif
#ifndef NAIVE_MASK
#define CONV_SPLIT 21
#define NAIVE_MASK 0
#endif

#define GAS __attribute__((address_space(1)))
#define LAS __attribute__((address_space(3)))
typedef unsigned short bf16_t;
typedef short bf16x8 __attribute__((ext_vector_type(8)));
typedef float f32x4 __attribute__((ext_vector_type(4)));
typedef float f32x2 __attribute__((ext_vector_type(2)));
typedef unsigned u32x4 __attribute__((ext_vector_type(4)));
typedef unsigned u32x2 __attribute__((ext_vector_type(2)));
typedef int i32x4 __attribute__((ext_vector_type(4)));
typedef int i32x8 __attribute__((ext_vector_type(8)));
typedef unsigned char fp8_t;

namespace mk {
constexpr int D = 1024, NB = 4, SEQ = 4096, NTOK = NB * SEQ, NMETA = 16;
constexpr int CW = 512, LW = 512, DIN = 2048, CK = 31, NE = 32, TOPK = 4, NH = 8, HD = 64;
constexpr int NPAIR = NTOK * TOPK;
constexpr int ACT_ROWS = NPAIR + NE * 256;
constexpr int NTHREADS = 512, NWAVES = 8;
constexpr int TT = 64;
constexpr int NTILE = SEQ / TT;
constexpr float NORM_EPS = 1e-6f, LN_EPS = 1e-5f;

constexpr size_t MiB = 1u << 20, KiB = 1u << 10;
constexpr size_t WS_CTL = 0, CTL_ZERO_BYTES = 64 * KiB;
constexpr size_t WS_WINT = 1 * MiB;
constexpr size_t WS_WOUTT = 5 * MiB;
constexpr size_t WS_WAT = 7 * MiB;
constexpr size_t WS_WXT = 7 * MiB + 64 * KiB;
constexpr size_t WS_WR = 7 * MiB + 128 * KiB;
constexpr size_t WS_UMETA = 7 * MiB + 256 * KiB;
constexpr size_t WS_ZMETA = 7 * MiB + 320 * KiB;
constexpr size_t WS_HMETA = 7 * MiB + 384 * KiB;
constexpr size_t WS_SUMM = 8 * MiB;
constexpr size_t WS_LIST = 9 * MiB;
constexpr size_t WS_GATEW = 11 * MiB;
constexpr size_t WS_HIST = 11 * MiB + 512 * KiB;
constexpr size_t WS_LISTG = 13 * MiB;
constexpr size_t WS_PINFO = 12 * MiB;
constexpr size_t WS_WGUT = 16 * MiB;
constexpr size_t WS_WDT = 144 * MiB;
constexpr size_t WS_U0 = 208 * MiB;
constexpr size_t WS_Z = 240 * MiB;
constexpr size_t WS_MIX = 304 * MiB;
constexpr size_t WS_H1 = 336 * MiB;
constexpr size_t WS_U1 = 400 * MiB;
constexpr size_t WS_ACT = 432 * MiB;
constexpr size_t WS_Y = 576 * MiB;
constexpr size_t WS_AB = 640 * MiB;
constexpr size_t WS_END = 704 * MiB;
constexpr int CW_BAR = 4096;
constexpr int CW_CNT = 8192;

constexpr int LDS_BYTES = 147456;
constexpr int LDS_TAB = 135168;
constexpr int LDS_IDS = 144384;
constexpr int LDS_PF = 138240, PF_BYTES = 3072;
constexpr int LDS_BARW = LDS_BYTES - 64;

__device__ __forceinline__ unsigned f2bf(float f) { unsigned u = __float_as_uint(f); return (u + 0x7fffu + ((u >> 16) & 1u)) >> 16; }
__device__ __forceinline__ float bf2f(unsigned b) { return __uint_as_float(b << 16); }
__device__ __forceinline__ float bflo(unsigned w) { return __uint_as_float(w << 16); }
__device__ __forceinline__ float bfhi(unsigned w) { return __uint_as_float(w & 0xffff0000u); }
__device__ __forceinline__ unsigned pk2(float lo, float hi) { return f2bf(lo) | (f2bf(hi) << 16); }
__device__ __forceinline__ unsigned pk4_fp8(float a, float b, float c, float d) { int w = 0; w = __builtin_amdgcn_cvt_pk_fp8_f32(a, b, w, false); w = __builtin_amdgcn_cvt_pk_fp8_f32(c, d, w, true); return (unsigned)w; }
constexpr float W8_SCALE = 64.0f, A8_SCALE = 4.0f, Y8_SCALE = 16.0f;
constexpr int W8_E8M0 = 0x79797979, A8_E8M0 = 0x7d7d7d7d;
__device__ __forceinline__ float wave_sum(float v) {
#pragma unroll
    for (int o = 1; o < 64; o <<= 1) v += __shfl_xor(v, o);
    return v;
}
__device__ __forceinline__ float sigmoidf_(float x) { return __builtin_amdgcn_rcpf(1.0f + __expf(-x)); }
__device__ __forceinline__ float gelu_tanh(float x) {
    const float u = 0.7978845608028654f * (x + 0.044715f * x * x * x);
    const float t = 1.0f - 2.0f * __builtin_amdgcn_rcpf(1.0f + __expf(2.0f * u));
    return 0.5f * x * (1.0f + t);
}

#define XB_TMO      128
#define XB_XCNT(j)  (256  + 64 * (j))
#define XB_XSUB(j)  (1280 + 64 * (j))
#define XB_XGEN(j)  (2304 + 64 * (j))
#define XB_TOP      3328
#define XB_TOPGEN   3392
#define XCD_BAR_WORDS 3456
#define XB_SPIN_CAP (1u << 18)

__device__ __forceinline__ unsigned xb_ld(unsigned* p)              { return __hip_atomic_load(p, __ATOMIC_RELAXED, __HIP_MEMORY_SCOPE_AGENT); }
__device__ __forceinline__ unsigned xb_add(unsigned* p, unsigned v) { return __hip_atomic_fetch_add(p, v, __ATOMIC_RELAXED, __HIP_MEMORY_SCOPE_AGENT); }
__device__ __forceinline__ unsigned xb_xcc_id() { return (unsigned)__builtin_amdgcn_s_getreg((3 << 11) | 20) & 0xFu; }
#define XB_SPIN(cond, bar) do { unsigned _sp = 0; while (cond) { __builtin_amdgcn_s_sleep(1); \
    if ((++_sp & 255u) == 0u) { if (xb_ld(&(bar)[XB_TMO])) break; if (_sp > XB_SPIN_CAP) { atomicAdd(&(bar)[XB_TMO], 1u); break; } } } } while (0)

struct XcdBarrier {
    unsigned* bar; unsigned x;
    volatile LAS unsigned* st;
};
__device__ __forceinline__ XcdBarrier xcd_barrier_post(unsigned* bar, volatile LAS unsigned* st) {
    XcdBarrier b; b.bar = bar; b.x = xb_xcc_id(); b.st = st;
    if (threadIdx.x == 0) (void)xb_add(&bar[XB_XCNT(b.x)], 1u);
    return b;
}
__device__ __forceinline__ void xcd_barrier_complete(unsigned* bar, unsigned x, unsigned& nloc, unsigned& nx) {
    const unsigned G = gridDim.x * gridDim.y * gridDim.z;
    unsigned sum, cnt, mine, sp = 0u;
    for (;;) {
        sum = 0u; cnt = 0u; mine = 0u;
#pragma unroll
        for (unsigned j = 0; j < 16; ++j) { const unsigned c = xb_ld(&bar[XB_XCNT(j)]); sum += c; cnt += (c > 0u) ? 1u : 0u; mine = (j == x) ? c : mine; }
        if (sum == G) break;
        __builtin_amdgcn_s_sleep(1);
        if ((++sp & 255u) == 0u) { if (xb_ld(&bar[XB_TMO])) break; if (sp > XB_SPIN_CAP) { atomicAdd(&bar[XB_TMO], 1u); break; } }
    }
    nloc = mine > 0u ? mine : 1u; nx = cnt > 0u ? cnt : 1u;
}
__device__ __forceinline__ void xcd_barrier(const XcdBarrier& b) {
    asm volatile("s_waitcnt vmcnt(0)" ::: "memory");
    __syncthreads();
    if (threadIdx.x == 0) {
        unsigned* bar = b.bar;
        __builtin_amdgcn_s_waitcnt(0);
        unsigned nloc = b.st[0], nx = b.st[1];
        if (nloc == 0u) { xcd_barrier_complete(bar, b.x, nloc, nx); b.st[0] = nloc; b.st[1] = nx; }
        const unsigned old = xb_add(&bar[XB_XSUB(b.x)], 1u);
        const unsigned gen = old / nloc;
        if (old + 1u == (gen + 1u) * nloc) {
            __builtin_amdgcn_fence(__ATOMIC_RELEASE, "agent");
            asm volatile("s_waitcnt vmcnt(0)" ::: "memory");
            const unsigned og = xb_add(&bar[XB_TOP], 1u);
            const unsigned tg = og / nx;
            if (og + 1u == (tg + 1u) * nx) xb_add(&bar[XB_TOPGEN], 1u);
            else XB_SPIN(xb_ld(&bar[XB_TOPGEN]) == tg, bar);
            __builtin_amdgcn_fence(__ATOMIC_ACQUIRE, "agent");
            xb_add(&bar[XB_XGEN(b.x)], 1u);
            asm volatile("s_waitcnt vmcnt(0)" ::: "memory");
        } else {
            XB_SPIN(xb_ld(&bar[XB_XGEN(b.x)]) == gen, bar);
            __builtin_amdgcn_fence(__ATOMIC_ACQUIRE, "agent");
            asm volatile("s_waitcnt vmcnt(0)" ::: "memory");
        }
    }
    __syncthreads();
}

struct Params {
    const float* in[24];
    float* out;
    unsigned char* ws;
    int ph_lo, ph_hi;
};
enum { I_X = 0, I_META, I_GMIX, I_WIN, I_CDW, I_CDB, I_CLNG, I_CLNB, I_LCW, I_LCB, I_WA, I_BA, I_WX, I_BX, I_LAM, I_WOUT, I_GFFN, I_WROUTER, I_BROUTER, I_WGU, I_BGU, I_WD, I_BD, I_GFINAL };

constexpr int BM = 256, BK = 64, HALF = 128, HTB = HALF * BK * 2, STAGE_BYTES = 8 * HTB, GK = 1024;
__device__ __forceinline__ int lds_byte(int r, int c) { const int st = (r >> 4) * 2 + (c >> 5), rr = r & 15, cc = c & 31, ob = rr * 64 + cc * 2; return st * 1024 + (ob ^ (((ob >> 9) & 1) << 5)); }
__device__ __forceinline__ void stage_rc(int b, int& R, int& C) { const int st = b / 1024, sb = b % 1024, swz = sb ^ (((sb >> 9) & 1) << 5); R = (st >> 1) * 16 + swz / 64; C = (st & 1) * 32 + (swz % 64) / 2; }
__device__ __forceinline__ int perm32(int rho) { const int n = rho >> 4, i = rho & 15; return 8 * (i >> 2) + 4 * n + (i & 3); }
__device__ __forceinline__ unsigned cvt_pk_bf16(float lo, float hi) { unsigned r; asm volatile("v_cvt_pk_bf16_f32 %0, %1, %2" : "=v"(r) : "v"(lo), "v"(hi)); return r; }

template <class T> __device__ __forceinline__ T* launder(T* p) { asm volatile("" : "+s"(p)); return p; }
struct Unit { int pm, pn, e, rows, rt; };
__device__ __forceinline__ void mfma_fp8_inplace(f32x4& acc, const i32x8& w, const i32x8& x, int sw, int sx) {
    asm volatile("v_mfma_scale_f32_16x16x128_f8f6f4 %0, %1, %2, %0, %3, %4 op_sel_hi:[0,0,0]" : "+v"(acc) : "v"(w), "v"(x), "v"(sw), "v"(sx));
}

template <class P, bool FP8>
__device__ __forceinline__ void gemm_phase(LAS unsigned char* lds, const P& S) {
    const int tid = threadIdx.x, wid = __builtin_amdgcn_readfirstlane(tid >> 6), lane = tid & 63, wr = wid >> 2, wc = wid & 3, fr = lane & 15, fq = lane >> 4;
    constexpr int K = GK, KB = FP8 ? K : 2 * K  , nt = KB / (BK * 2);
    constexpr bool GATHER = P::GATHER;
    unsigned voffB[2], voffA[2], c2 = 0;
#pragma unroll
    for (int i = 0; i < 2; ++i) { int pR, pC; stage_rc(tid * 16 + i * 8192, pR, pC); const int Rb = P::PERM ? ((pR & ~31) + perm32(pR & 31)) : pR; voffB[i] = (unsigned)(Rb * KB + pC * 2); voffA[i] = (unsigned)(pR * KB + pC * 2); c2 = (unsigned)(pC * 2); }
    const size_t kstep = (size_t)(BK * 2);
    const size_t hstep = (size_t)HALF * KB;
    const unsigned ldsw = (unsigned)wid * 1024u;
    const int aoff = lds_byte(wr * 64 + fr, fq * 8), boff = lds_byte(wc * 32 + fr, fq * 8);
#define PG8_SA(b, h) (((b) * 2 + (h)) * HTB)
#define PG8_SB(b, h) ((4 + (b) * 2 + (h)) * HTB)
#define PG8_STAGE(bufoff, gbase, voff) do { _Pragma("unroll") for (int _i = 0; _i < 2; ++_i) \
        __builtin_amdgcn_global_load_lds((const unsigned*)((const char*)(gbase) + (voff)[_i]), (LAS unsigned*)(lds + (bufoff) + ldsw + _i * 8192), 16, 0, 0); } while (0)
#define PG8_STAGE_A(bufoff, gbase, h, PK) do { _Pragma("unroll") for (int _i = 0; _i < 2; ++_i) { \
        if constexpr (GATHER) { const unsigned _o = (((PK)[h] >> (16 * _i)) & 0xffffu) * (unsigned)KB + c2; \
            __builtin_amdgcn_global_load_lds((const unsigned*)((const char*)(gbase) + _o), (LAS unsigned*)(lds + (bufoff) + ldsw + _i * 8192), 16, 0, 0); } \
        else __builtin_amdgcn_global_load_lds((const unsigned*)((const char*)(gbase) + (h) * hstep + voffA[_i]), (LAS unsigned*)(lds + (bufoff) + ldsw + _i * 8192), 16, 0, 0); } } while (0)
#define PG8_LDA(dst, b, h) do { _Pragma("unroll") for (int m = 0; m < 4; ++m) { \
        if constexpr (FP8) { const i32x4 lo_ = *(const LAS i32x4*)(lds + PG8_SA(b, h) + aoff + m * 2048), hi_ = *(const LAS i32x4*)(lds + PG8_SA(b, h) + aoff + m * 2048 + 1024); dst##8[m] = __builtin_shufflevector(lo_, hi_, 0, 1, 2, 3, 4, 5, 6, 7); } \
        else { _Pragma("unroll") for (int k = 0; k < 2; ++k) dst[m][k] = *(const LAS bf16x8*)(lds + PG8_SA(b, h) + aoff + m * 2048 + k * 1024); } } } while (0)
#define PG8_LDB(dst, b, h) do { _Pragma("unroll") for (int n = 0; n < 2; ++n) { \
        if constexpr (FP8) { const i32x4 lo_ = *(const LAS i32x4*)(lds + PG8_SB(b, h) + boff + n * 2048), hi_ = *(const LAS i32x4*)(lds + PG8_SB(b, h) + boff + n * 2048 + 1024); dst##8[n] = __builtin_shufflevector(lo_, hi_, 0, 1, 2, 3, 4, 5, 6, 7); } \
        else { _Pragma("unroll") for (int k = 0; k < 2; ++k) dst[n][k] = *(const LAS bf16x8*)(lds + PG8_SB(b, h) + boff + n * 2048 + k * 1024); } } } while (0)
#define PG8_MMA(ai, bj, At, Bt) do { __builtin_amdgcn_s_setprio(1); _Pragma("unroll") for (int m = 0; m < 4; ++m) _Pragma("unroll") for (int n = 0; n < 2; ++n) { \
        if constexpr (FP8) mfma_fp8_inplace(acc[ai][bj][m][n], Bt##8[n], At##8[m], sc_w, sc_x); \
        else { _Pragma("unroll") for (int k = 0; k < 2; ++k) acc[ai][bj][m][n] = __builtin_amdgcn_mfma_f32_16x16x32_bf16(Bt[n][k], At[m][k], acc[ai][bj][m][n], 0, 0, 0); } } \
        __builtin_amdgcn_s_setprio(0); } while (0)
#define PG8_WAIT_V(n) asm volatile("s_waitcnt vmcnt(" #n ")" ::: "memory")
#define PG8_WAIT_L(n) asm volatile("s_waitcnt lgkmcnt(" #n ")" ::: "memory")
#define PG8_BAR __builtin_amdgcn_s_barrier()
#define PG8_SCHED __builtin_amdgcn_sched_barrier(0)
    Unit cur, nxt; int ui = 0;
    if (!S.next(0, cur)) return;
    unsigned cpk[2] = {0u, 0u}, npk[2] = {0u, 0u};
    if constexpr (GATHER) S.a_rows(cur, cpk);
    bool has_next = S.next(1, nxt);
    if constexpr (GATHER) { npk[0] = cpk[0]; npk[1] = cpk[1]; if (has_next) S.ids_prefetch(nxt, lds + LDS_IDS + 1024, wid, lane); }
    f32x4 acc[2][2][4][2];
#pragma unroll
    for (int a = 0; a < 2; ++a)
#pragma unroll
        for (int b = 0; b < 2; ++b)
#pragma unroll
            for (int m = 0; m < 4; ++m)
#pragma unroll
                for (int n = 0; n < 2; ++n) acc[a][b][m][n] = (f32x4){0.f, 0.f, 0.f, 0.f};
    bf16x8 At[4][2], B0[2][2], B1[2][2]; i32x8 At8[4], B08[2], B18[2];
    int sc_w = W8_E8M0, sc_x = A8_E8M0; asm volatile("" : "+v"(sc_w), "+v"(sc_x));
    const char* cA = S.a_base(cur); const char* cB = S.b_base(cur);
    S.prefetch(cur, lds + LDS_PF, wid, lane);
    PG8_STAGE(PG8_SB(0, 0), cB, voffB); PG8_STAGE_A(PG8_SA(0, 0), cA, 0, cpk); PG8_STAGE(PG8_SB(0, 1), cB + hstep, voffB); PG8_STAGE_A(PG8_SA(0, 1), cA, 1, cpk);
    if (wr == 1) PG8_BAR;
    PG8_WAIT_V(4); PG8_BAR;
    PG8_STAGE(PG8_SB(1, 0), cB + kstep, voffB); PG8_STAGE_A(PG8_SA(1, 0), cA + kstep, 0, cpk); PG8_STAGE(PG8_SB(1, 1), cB + hstep + kstep, voffB);
    PG8_WAIT_V(6); PG8_BAR;
    for (;;) {
        const char* nA = has_next ? S.a_base(nxt) : cA; const char* nB = has_next ? S.b_base(nxt) : cB;
#pragma unroll 1
        for (int t = 0; t < nt; t += 2) {
            const bool last = (t == nt - 2);
            const char* a1 = cA + (size_t)(t + 1) * kstep;
            const char* a2 = last ? nA : cA + (size_t)(t + 2) * kstep; const char* b2 = last ? nB : cB + (size_t)(t + 2) * kstep;
            const char* a3 = a2 + kstep; const char* b3 = b2 + kstep;
            if constexpr (GATHER) { if (last && has_next) S.ids_read(nxt, lds + LDS_IDS + ((ui + 1) & 1) * 1024, npk); }
            PG8_LDB(B0, 0, 0); PG8_SCHED; PG8_LDA(At, 0, 0); PG8_STAGE_A(PG8_SA(1, 1), a1, 1, cpk);
            if constexpr (GATHER) { if (last) { cpk[0] = npk[0]; cpk[1] = npk[1]; } }
            PG8_WAIT_L(8); PG8_BAR; PG8_WAIT_L(0); PG8_MMA(0, 0, At, B0); PG8_BAR; PG8_SCHED;
            PG8_LDB(B1, 0, 1); PG8_STAGE(PG8_SB(0, 0), b2, voffB);
            PG8_BAR; PG8_WAIT_L(0); PG8_MMA(0, 1, At, B1); PG8_BAR;
            PG8_LDA(At, 0, 1); PG8_STAGE_A(PG8_SA(0, 0), a2, 0, cpk);
            PG8_BAR; PG8_WAIT_L(0); PG8_MMA(1, 0, At, B0); PG8_BAR; PG8_SCHED;
            PG8_STAGE(PG8_SB(0, 1), b2 + hstep, voffB);
            PG8_WAIT_V(6); PG8_BAR; PG8_MMA(1, 1, At, B1); PG8_BAR;
            PG8_LDB(B0, 1, 0); PG8_SCHED; PG8_LDA(At, 1, 0); PG8_STAGE_A(PG8_SA(0, 1), a2, 1, cpk);
            PG8_WAIT_L(8); PG8_BAR; PG8_WAIT_L(0); PG8_MMA(0, 0, At, B0); PG8_BAR; PG8_SCHED;
            PG8_LDB(B1, 1, 1); PG8_STAGE(PG8_SB(1, 0), b3, voffB);
            PG8_BAR; PG8_WAIT_L(0); PG8_MMA(0, 1, At, B1); PG8_BAR;
            PG8_LDA(At, 1, 1); PG8_STAGE_A(PG8_SA(1, 0), a3, 0, cpk);
            PG8_BAR; PG8_WAIT_L(0); PG8_MMA(1, 0, At, B0); PG8_BAR; PG8_SCHED;
            PG8_STAGE(PG8_SB(1, 1), b3 + hstep, voffB);
            PG8_WAIT_V(6); PG8_BAR; PG8_MMA(1, 1, At, B1); PG8_BAR;
        }
        if constexpr (FP8) {
#pragma unroll
            for (int a = 0; a < 2; ++a)
#pragma unroll
                for (int b = 0; b < 2; ++b)
                    asm volatile("s_nop 15\n\ts_nop 15" : "+v"(acc[a][b][0][0]), "+v"(acc[a][b][0][1]), "+v"(acc[a][b][1][0]), "+v"(acc[a][b][1][1]), "+v"(acc[a][b][2][0]), "+v"(acc[a][b][2][1]), "+v"(acc[a][b][3][0]), "+v"(acc[a][b][3][1]) :: "memory");
        }
        Unit nn = nxt; const bool has_nn = has_next ? S.next(ui + 2, nn) : false;
        S.epi(acc, cur, wr, wc, fr, fq, lds + LDS_PF + (ui & 1) * PF_BYTES);
        if (!has_next) break;
#pragma unroll
        for (int a = 0; a < 2; ++a)
#pragma unroll
            for (int b = 0; b < 2; ++b)
#pragma unroll
                for (int m = 0; m < 4; ++m)
#pragma unroll
                    for (int n = 0; n < 2; ++n) acc[a][b][m][n] = (f32x4){0.f, 0.f, 0.f, 0.f};
        cur = nxt; cA = nA; cB = nB; ++ui;
        S.prefetch(cur, lds + LDS_PF + (ui & 1) * PF_BYTES, wid, lane);
        nxt = nn; has_next = has_nn;
        if constexpr (GATHER) { if (has_next) S.ids_prefetch(nxt, lds + LDS_IDS + ((ui + 1) & 1) * 1024, wid, lane); }
    }
    PG8_WAIT_V(0);
    if (wr == 0) PG8_BAR;
    PG8_BAR;
#undef PG8_SA
#undef PG8_SB
#undef PG8_STAGE
#undef PG8_STAGE_A
#undef PG8_LDA
#undef PG8_LDB
#undef PG8_MMA
#undef PG8_WAIT_V
#undef PG8_WAIT_L
#undef PG8_BAR
#undef PG8_SCHED
}

__device__ __forceinline__ bool static_next(int i, int G, int c, int nM, int nN, Unit& u) {
    const int nwg = nM * nN; const long L = (long)i * G + c; if (L >= nwg) return false;
    int wgid = (int)L; { const int q = nwg / 8, r = nwg % 8, xcd = wgid % 8, off = wgid / 8; wgid = (xcd < r ? xcd * (q + 1) : r * (q + 1) + (xcd - r) * q) + off; }
    const int nig = 8 * nN, gid = wgid / nig, fm = gid * 8, gsz = (nM - fm) < 8 ? (nM - fm) : 8;
    u.pm = fm + ((wgid % nig) % gsz); u.pn = (wgid % nig) / gsz; u.e = 0; u.rows = 256; u.rt = u.pm; return true;
}

struct ProbIn {
    static constexpr bool PERM = true, GATHER = false;
    const bf16_t* A; const bf16_t* Bt; bf16_t* O; int G, c;
    __device__ __forceinline__ bool next(int i, Unit& u) const { return static_next(i, G, c, NTOK / BM, DIN / BM, u); }
    __device__ __forceinline__ void prefetch(const Unit&, LAS unsigned char*, int, int) const {}
    __device__ __forceinline__ const char* a_base(const Unit& u) const { return (const char*)A + (size_t)u.pm * BM * GK * 2; }
    __device__ __forceinline__ const char* b_base(const Unit& u) const { return (const char*)Bt + (size_t)u.pn * BM * GK * 2; }
    __device__ __forceinline__ void epi(const f32x4 (&acc)[2][2][4][2], const Unit& u, int wr, int wc, int fr, int fq, const LAS unsigned char* pf) const {
        int row0 = u.pm * BM + wr * 64 + fr, col0 = u.pn * BM + wc * 32 + 8 * fq;
        asm volatile("" : "+v"(row0), "+v"(col0));
        auto Ob = launder(O);
#pragma unroll
        for (int ai = 0; ai < 2; ++ai)
#pragma unroll
            for (int m = 0; m < 4; ++m) { auto rowp = Ob + (size_t)(row0 + ai * HALF + m * 16) * DIN + col0;
#pragma unroll
                for (int bj = 0; bj < 2; ++bj) { const f32x4 v0 = acc[ai][bj][m][0], v1 = acc[ai][bj][m][1];
                    u32x4 w; w.x = cvt_pk_bf16(v0[0], v0[1]); w.y = cvt_pk_bf16(v0[2], v0[3]); w.z = cvt_pk_bf16(v1[0], v1[1]); w.w = cvt_pk_bf16(v1[2], v1[3]);
                    *(u32x4*)(rowp + bj * HALF) = w; } }
    }
};
struct ProbOut {
    static constexpr bool PERM = true, GATHER = false;
    const bf16_t* A; const bf16_t* Bt; const float* X; bf16_t* O; int G, c;
    __device__ __forceinline__ bool next(int i, Unit& u) const { return static_next(i, G, c, NTOK / BM, D / BM, u); }
    __device__ __forceinline__ void prefetch(const Unit&, LAS unsigned char*, int, int) const {}
    __device__ __forceinline__ const char* a_base(const Unit& u) const { return (const char*)A + (size_t)u.pm * BM * GK * 2; }
    __device__ __forceinline__ const char* b_base(const Unit& u) const { return (const char*)Bt + (size_t)u.pn * BM * GK * 2; }
    __device__ __forceinline__ void epi(const f32x4 (&acc)[2][2][4][2], const Unit& u, int wr, int wc, int fr, int fq, const LAS unsigned char* pf) const {
        int row0 = u.pm * BM + wr * 64 + fr, col0 = u.pn * BM + wc * 32 + 8 * fq;
        asm volatile("" : "+v"(row0), "+v"(col0));
        auto Xb = launder(X); auto Ob = launder(O);
#pragma unroll
        for (int ai = 0; ai < 2; ++ai) {
            f32x4 xv[4][2][2];
#pragma unroll
            for (int m = 0; m < 4; ++m) { const size_t ro = (size_t)(row0 + ai * HALF + m * 16) * D + col0;
#pragma unroll
                for (int bj = 0; bj < 2; ++bj)
#pragma unroll
                    for (int n = 0; n < 2; ++n) xv[m][bj][n] = *(const f32x4*)(Xb + ro + bj * HALF + n * 4); }
            __builtin_amdgcn_sched_barrier(0);
#pragma unroll
            for (int m = 0; m < 4; ++m) { const size_t ro = (size_t)(row0 + ai * HALF + m * 16) * D + col0;
#pragma unroll
                for (int bj = 0; bj < 2; ++bj) { const f32x4 v0 = acc[ai][bj][m][0] + xv[m][bj][0], v1 = acc[ai][bj][m][1] + xv[m][bj][1];
                    u32x4 w; w.x = cvt_pk_bf16(v0[0], v0[1]); w.y = cvt_pk_bf16(v0[2], v0[3]); w.z = cvt_pk_bf16(v1[0], v1[1]); w.w = cvt_pk_bf16(v1[2], v1[3]);
                    *(u32x4*)(Ob + ro + bj * HALF) = w; } }
        }
    }
};
struct MoeSched { const LAS int* cnt; const LAS int* tbase; int G, vcu; };
__device__ __forceinline__ bool moe_next(const MoeSched& M, int i, int ncol, Unit& u) {
    const int L = i * M.G + M.vcu, total = M.tbase[NE] * ncol; if (L >= total) return false;
    const int ln = (int)threadIdx.x & 63, tb = M.tbase[ln < NE ? ln + 1 : NE];
    const int e = (int)__popcll(__ballot(ln < NE - 1 && L >= tb * ncol));
    const int tiles = M.tbase[e + 1] - M.tbase[e], loc = L - M.tbase[e] * ncol;
    u.e = e; u.pn = loc / tiles; u.pm = loc % tiles; u.rt = M.tbase[e] + u.pm;
    const int rem = M.cnt[e] - u.pm * BM; u.rows = rem < BM ? rem : BM; return true;
}
struct ProbGU {
    static constexpr bool PERM = true, GATHER = true;
    const fp8_t* U1; const fp8_t* WguT; const float* bgu; const int* list; fp8_t* ACT; MoeSched M;
    __device__ __forceinline__ bool next(int i, Unit& u) const { return moe_next(M, i, 8, u); }
    __device__ __forceinline__ void ids_prefetch(const Unit& u, LAS unsigned char* ids, int wave, int lane) const {
        if (wave < 4) __builtin_amdgcn_global_load_lds((const unsigned*)(list + (size_t)u.e * NTOK + u.pm * BM + 64 * wave + lane), (LAS unsigned*)(ids + wave * 256), 4, 0, 0); }
    __device__ __forceinline__ void ids_read(const Unit& u, const LAS unsigned char* ids, unsigned (&pk)[2]) const {
        int pR, pC; stage_rc((int)threadIdx.x * 16, pR, pC);
#pragma unroll
        for (int h = 0; h < 2; ++h) { const int r0 = h * HALF + pR, r1 = r0 + 64;
            const int p0 = *(const LAS int*)(ids + 4 * ((r0 < u.rows) ? r0 : 0)), p1 = *(const LAS int*)(ids + 4 * ((r1 < u.rows) ? r1 : 0));
            pk[h] = (unsigned)(p0 >> 2) | ((unsigned)(p1 >> 2) << 16); }
    }
    __device__ __forceinline__ void prefetch(const Unit& u, LAS unsigned char* pf, int wave, int lane) const {
        if (wave < 4) __builtin_amdgcn_global_load_lds((const unsigned*)(bgu + (size_t)u.e * DIN + u.pn * BM + 64 * wave + lane), (LAS unsigned*)(pf + wave * 256), 4, 0, 0); }
    __device__ __forceinline__ const char* a_base(const Unit&) const { return (const char*)U1; }
    __device__ __forceinline__ const char* b_base(const Unit& u) const { return (const char*)WguT + ((size_t)u.e * DIN + (size_t)u.pn * BM) * GK; }
    __device__ __forceinline__ void a_rows(const Unit& u, unsigned (&pk)[2]) const {
        const int* le = list + (size_t)u.e * NTOK + u.pm * BM;
        int pR, pC; stage_rc((int)threadIdx.x * 16, pR, pC);
#pragma unroll
        for (int h = 0; h < 2; ++h) { const int r0 = h * HALF + pR, r1 = r0 + 64;
            const int p0 = (r0 < u.rows) ? le[r0] : le[0], p1 = (r1 < u.rows) ? le[r1] : le[0];
            pk[h] = (unsigned)(p0 >> 2) | ((unsigned)(p1 >> 2) << 16); }
    }
    __device__ __forceinline__ void epi(const f32x4 (&acc)[2][2][4][2], const Unit& u, int wr, int wc, int fr, int fq, const LAS unsigned char* pf) const {
        int j0 = u.pn * HALF + wc * 32 + 8 * fq;
        int row0 = wr * 64 + fr;
        asm volatile("" : "+v"(row0), "+v"(j0));
        auto ACTb = launder(ACT);
        const LAS f32x4* bp = (const LAS f32x4*)(pf + (wc * 64 + 16 * fq) * 4);
        const f32x4 b0 = bp[0], b1 = bp[1], b2 = bp[2], b3 = bp[3];
        const float bg[8] = {b0[0], b0[2], b1[0], b1[2], b2[0], b2[2], b3[0], b3[2]};
        const float bl[8] = {b0[1], b0[3], b1[1], b1[3], b2[1], b2[3], b3[1], b3[3]};
#pragma unroll
        for (int ai = 0; ai < 2; ++ai)
#pragma unroll
            for (int m = 0; m < 4; ++m) {
                const int r = row0 + ai * HALF + m * 16;
                float o[8];
#pragma unroll
                for (int n = 0; n < 2; ++n)
#pragma unroll
                    for (int x = 0; x < 4; x += 2) {
                        f32x2 g = (f32x2){acc[ai][0][m][n][x], acc[ai][0][m][n][x + 1]} + (f32x2){bg[4 * n + x], bg[4 * n + x + 1]};
                        f32x2 l = (f32x2){acc[ai][1][m][n][x], acc[ai][1][m][n][x + 1]} + (f32x2){bl[4 * n + x], bl[4 * n + x + 1]};
                        g[0] = fminf(g[0], 7.0f); g[1] = fminf(g[1], 7.0f);
                        l[0] = __builtin_amdgcn_fmed3f(l[0], -7.0f, 7.0f); l[1] = __builtin_amdgcn_fmed3f(l[1], -7.0f, 7.0f);
                        const f32x2 t = g * (-1.702f * 1.4426950408889634f);
                        f32x2 d; d[0] = __builtin_amdgcn_exp2f(t[0]); d[1] = __builtin_amdgcn_exp2f(t[1]);
                        d = d + 1.0f;
                        f32x2 r; r[0] = __builtin_amdgcn_rcpf(d[0]); r[1] = __builtin_amdgcn_rcpf(d[1]);
                        const f32x2 res = (g * r) * (l * A8_SCALE + A8_SCALE);
                        o[4 * n + x] = res[0]; o[4 * n + x + 1] = res[1];
                    }
                u32x2 w; w.x = pk4_fp8(o[0], o[1], o[2], o[3]); w.y = pk4_fp8(o[4], o[5], o[6], o[7]);
                *(u32x2*)(ACTb + ((size_t)u.rt * BM + r) * D + j0) = w;
            }
    }
};
struct ProbDown {
    static constexpr bool PERM = true, GATHER = false;
    const fp8_t* ACT; const fp8_t* WdT; const float* bd; const int* list; const float* gatew; fp8_t* Y; MoeSched M;
    __device__ __forceinline__ bool next(int i, Unit& u) const { return moe_next(M, i, 4, u); }
    __device__ __forceinline__ void prefetch(const Unit& u, LAS unsigned char* pf, int wave, int lane) const {
        const size_t o = (size_t)u.e * NTOK + u.pm * BM + 64 * (wave & 3) + lane;
        const unsigned* src = (wave < 4) ? (const unsigned*)(list + o) : (const unsigned*)(gatew + o);
        __builtin_amdgcn_global_load_lds(src, (LAS unsigned*)(pf + wave * 256), 4, 0, 0);
        if (wave < 4) __builtin_amdgcn_global_load_lds((const unsigned*)(bd + (size_t)u.e * D + u.pn * BM + 64 * wave + lane), (LAS unsigned*)(pf + 2048 + wave * 256), 4, 0, 0); }
    __device__ __forceinline__ const char* a_base(const Unit& u) const { return (const char*)ACT + (size_t)u.rt * BM * GK; }
    __device__ __forceinline__ const char* b_base(const Unit& u) const { return (const char*)WdT + ((size_t)u.e * D + (size_t)u.pn * BM) * GK; }
    __device__ __forceinline__ void epi(const f32x4 (&acc)[2][2][4][2], const Unit& u, int wr, int wc, int fr, int fq, const LAS unsigned char* pf) const {
        int col0 = u.pn * BM + wc * 32 + 8 * fq, row0 = wr * 64 + fr;
        asm volatile("" : "+v"(row0), "+v"(col0));
        auto Yb = launder(Y);
        f32x4 bv[2][2];
#pragma unroll
        for (int bj = 0; bj < 2; ++bj)
#pragma unroll
            for (int n = 0; n < 2; ++n) bv[bj][n] = *(const LAS f32x4*)(pf + 2048 + (wc * 32 + 8 * fq + bj * HALF + 4 * n) * 4);
        int pr[8]; float gw[8];
#pragma unroll
        for (int k = 0; k < 8; ++k) { const int r = row0 + (k >> 2) * HALF + (k & 3) * 16; pr[k] = *(const LAS int*)(pf + 4 * r); gw[k] = *(const LAS float*)(pf + 1024 + 4 * r); }
#pragma unroll
        for (int ai = 0; ai < 2; ++ai)
#pragma unroll
            for (int m = 0; m < 4; ++m) {
                const int r = row0 + ai * HALF + m * 16, k = ai * 4 + m;
                u32x2 w[2];
#pragma unroll
                for (int bj = 0; bj < 2; ++bj) { const f32x4 v0 = (acc[ai][bj][m][0] + bv[bj][0]) * (gw[k] * Y8_SCALE), v1 = (acc[ai][bj][m][1] + bv[bj][1]) * (gw[k] * Y8_SCALE);
                    w[bj].x = pk4_fp8(v0[0], v0[1], v0[2], v0[3]); w[bj].y = pk4_fp8(v1[0], v1[1], v1[2], v1[3]); }
                if (r < u.rows) { auto rowp = Yb + (size_t)pr[k] * D + col0; *(u32x2*)(rowp) = w[0]; *(u32x2*)(rowp + HALF) = w[1]; }
            }
    }
};

__device__ __forceinline__ float wave_dot_bf16(const bf16_t* a, const bf16_t* b, int lane) {
    const u32x4 a0 = *(const u32x4*)(a + 16 * lane), a1 = *(const u32x4*)(a + 16 * lane + 8);
    const u32x4 b0 = *(const u32x4*)(b + 16 * lane), b1 = *(const u32x4*)(b + 16 * lane + 8);
    float s = 0.f;
#pragma unroll
    for (int j = 0; j < 4; ++j) { s += bflo(a0[j]) * bflo(b0[j]) + bfhi(a0[j]) * bfhi(b0[j]); s += bflo(a1[j]) * bflo(b1[j]) + bfhi(a1[j]) * bfhi(b1[j]); }
    return wave_sum(s);
}

struct Frame {
    LAS unsigned char* lds;
    int tid, lane, wave, G, vcu, gw, NGW;
    const float* in[24]; float* out; unsigned char* ws;
    unsigned* ctl;
    bf16_t *WinT, *WoutT, *WaT, *WxT, *UMETA, *ZMETA, *U0, *Z, *MIX;
    fp8_t *WguT, *WdT, *U1, *ACT, *Y;
    float *WR, *HMETA, *SUMM, *GATEW; bf16_t* H1;
    int* LIST;
};

template <int MAP, bool FP8, bool NT = false>
__device__ __forceinline__ void p0_transpose_item(const float* W, int K, int N, void* WTv, LAS float* scr, int item, int lane) {
    const int nblk = N / 64, kb = item / nblk, nb = item % nblk, k0 = 64 * kb, n0 = 64 * nb;
    {
        f32x4 v[16];
#pragma unroll
        for (int i = 0; i < 16; ++i) { const int kk = 4 * i + (lane >> 4); const f32x4* wp = (const f32x4*)(W + (size_t)(k0 + kk) * N + n0 + 4 * (lane & 15)); v[i] = NT ? __builtin_nontemporal_load(wp) : *wp; }
        __builtin_amdgcn_sched_barrier(0);
#pragma unroll
        for (int i = 0; i < 16; ++i) { const int kk = 4 * i + (lane >> 4); LAS float* s = scr + kk * 65 + 4 * (lane & 15); s[0] = v[i][0]; s[1] = v[i][1]; s[2] = v[i][2]; s[3] = v[i][3]; }
    }
    asm volatile("s_waitcnt lgkmcnt(0)" ::: "memory");
    const int c = lane & 7;
#pragma unroll
    for (int j = 0; j < 8; ++j) { const int n = (lane >> 3) + 8 * j; const LAS float* s = scr + (8 * c) * 65 + n;
        const int ng = n0 + n; int row = ng;
        if (MAP == 1) { const int jj = ng >> 1, half = ng & 1; row = (jj >> 7) * 256 + half * 128 + (jj & 127); }
        if (FP8) { u32x2 o; o.x = pk4_fp8(s[0 * 65] * W8_SCALE, s[1 * 65] * W8_SCALE, s[2 * 65] * W8_SCALE, s[3 * 65] * W8_SCALE); o.y = pk4_fp8(s[4 * 65] * W8_SCALE, s[5 * 65] * W8_SCALE, s[6 * 65] * W8_SCALE, s[7 * 65] * W8_SCALE);
            *(u32x2*)((fp8_t*)WTv + (size_t)row * K + k0 + 8 * c) = o; }
        else { u32x4 o; o.x = pk2(s[0 * 65], s[1 * 65]); o.y = pk2(s[2 * 65], s[3 * 65]); o.z = pk2(s[4 * 65], s[5 * 65]); o.w = pk2(s[6 * 65], s[7 * 65]);
            *(u32x4*)((bf16_t*)WTv + (size_t)row * K + k0 + 8 * c) = o; } }
    asm volatile("s_waitcnt lgkmcnt(0)" ::: "memory");
}
__device__ __forceinline__ void rms_row_to_bf16(const float* xrow, const float* g, bf16_t* orow, int lane) {
    f32x4 v[4]; float s = 0.f;
#pragma unroll
    for (int j = 0; j < 4; ++j) { v[j] = *(const f32x4*)(xrow + 4 * lane + 256 * j); s += (v[j][0] * v[j][0] + v[j][1] * v[j][1]) + (v[j][2] * v[j][2] + v[j][3] * v[j][3]); }
    const float rstd = 1.0f / sqrtf(wave_sum(s) * (1.0f / D) + NORM_EPS);
#pragma unroll
    for (int j = 0; j < 4; ++j) { const f32x4 gv = *(const f32x4*)(g + 4 * lane + 256 * j);
        u32x2 o; o.x = pk2(v[j][0] * rstd * gv[0], v[j][1] * rstd * gv[1]); o.y = pk2(v[j][2] * rstd * gv[2], v[j][3] * rstd * gv[3]);
        *(u32x2*)(orow + 4 * lane + 256 * j) = o; }
}
__device__ __forceinline__ void expert_weights_to_fp8(Frame& F, int vw, int nvw, int k_lo, int k_hi) {
    LAS float* scr = (LAS float*)(F.lds + 4096 + F.wave * 16640);
    constexpr int I_GU = NE * (D / 64) * (DIN / 64), I_D = NE * (D / 64) * (D / 64);
    for (int k = k_lo; k < k_hi; ++k) {
        int r = k * nvw + vw; if (r >= I_D + I_GU) break;
        if (r < I_D) { const int e = r / (I_D / NE), q = r % (I_D / NE); p0_transpose_item<0, true, true>(F.in[I_WD] + (size_t)e * D * D, D, D, F.WdT + (size_t)e * D * D, scr, q, F.lane); continue; } r -= I_D;
        { const int e = r / (I_GU / NE), q = r % (I_GU / NE); p0_transpose_item<1, true, true>(F.in[I_WGU] + (size_t)e * D * DIN, D, DIN, F.WguT + (size_t)e * DIN * D, scr, q, F.lane); }
    }
}
__device__ __forceinline__ void p0_prologue(Frame& F) {
    LAS float* scr = (LAS float*)(F.lds + F.wave * 16640);
    constexpr int I_IN = (D / 64) * (DIN / 64), I_OUT = (D / 64) * (D / 64), I_G = 2 * NH;
    constexpr int NITEMS = I_IN + I_OUT + I_G;
    for (int it = F.gw; it < NITEMS; it += F.NGW) {
        int r = it;
        if (r < I_IN) { p0_transpose_item<0, false>(F.in[I_WIN], D, DIN, F.WinT, scr, r, F.lane); continue; } r -= I_IN;
        if (r < I_OUT) { p0_transpose_item<0, false>(F.in[I_WOUT], D, D, F.WoutT, scr, r, F.lane); continue; } r -= I_OUT;
        { const int h = r >> 1; if (r & 1) p0_transpose_item<0, false>(F.in[I_WX] + h * HD * HD, HD, HD, F.WxT + h * HD * HD, scr, 0, F.lane);
          else p0_transpose_item<0, false>(F.in[I_WA] + h * HD * HD, HD, HD, F.WaT + h * HD * HD, scr, 0, F.lane); }
    }
    {
        f32x4 gv[4];
#pragma unroll
        for (int j = 0; j < 4; ++j) gv[j] = *(const f32x4*)(F.in[I_GMIX] + 4 * F.lane + 256 * j);
#pragma unroll 1
        for (int m0 = F.gw; m0 < NTOK + NMETA; m0 += 4 * F.NGW) {
            f32x4 v[4][4]; float ss[4];
#pragma unroll
            for (int i = 0; i < 4; ++i) { int m = m0 + i * F.NGW; m = m < NTOK + NMETA ? m : m0;
                const float* xr = (m < NTOK) ? F.in[I_X] + (size_t)m * D : F.in[I_META] + (size_t)(m - NTOK) * D;
#pragma unroll
                for (int j = 0; j < 4; ++j) v[i][j] = *(const f32x4*)(xr + 4 * F.lane + 256 * j); }
            __builtin_amdgcn_sched_barrier(0);
#pragma unroll
            for (int i = 0; i < 4; ++i) { float sq = 0.f;
#pragma unroll
                for (int j = 0; j < 4; ++j) sq += (v[i][j][0] * v[i][j][0] + v[i][j][1] * v[i][j][1]) + (v[i][j][2] * v[i][j][2] + v[i][j][3] * v[i][j][3]);
                ss[i] = sq; }
#pragma unroll
            for (int o = 1; o < 64; o <<= 1) {
#pragma unroll
                for (int i = 0; i < 4; ++i) ss[i] += __shfl_xor(ss[i], o); }
#pragma unroll
            for (int i = 0; i < 4; ++i) { const int m = m0 + i * F.NGW;
                if (m < NTOK + NMETA) { const float rstd = 1.0f / sqrtf(ss[i] * (1.0f / D) + NORM_EPS);
                    bf16_t* orow = (m < NTOK) ? F.U0 + (size_t)m * D : F.UMETA + (size_t)(m - NTOK) * D;
#pragma unroll
                    for (int j = 0; j < 4; ++j) { u32x2 o; o.x = pk2(v[i][j][0] * rstd * gv[j][0], v[i][j][1] * rstd * gv[j][1]); o.y = pk2(v[i][j][2] * rstd * gv[j][2], v[i][j][3] * rstd * gv[j][3]);
                        *(u32x2*)(orow + 4 * F.lane + 256 * j) = o; } } }
        }
    }
    for (int i = blockIdx.x * NTHREADS + F.tid; i < D * NE; i += F.G * NTHREADS) { const int k = i >> 5, e = i & 31; const float w = F.in[I_GFFN][k] * F.in[I_WROUTER][i];
        const unsigned hi = f2bf(w), lo = f2bf(w - bf2f(hi)); bf16_t* wr = (bf16_t*)F.WR; wr[e * D + k] = (bf16_t)hi; wr[NE * D + e * D + k] = (bf16_t)lo; }
}

__device__ __forceinline__ void p1_zmeta(Frame& F) {
    for (int n = F.gw; n < DIN; n += F.NGW) {
        const bf16_t* wrow = F.WinT + (size_t)n * D + 16 * F.lane;
        const u32x4 b0 = *(const u32x4*)(wrow), b1 = *(const u32x4*)(wrow + 8);
#pragma unroll 1
        for (int r0 = 0; r0 < NMETA; r0 += 8) {
            u32x4 a0[8], a1[8]; float s[8];
#pragma unroll
            for (int i = 0; i < 8; ++i) { const bf16_t* ar = F.UMETA + (size_t)(r0 + i) * D + 16 * F.lane; a0[i] = *(const u32x4*)(ar); a1[i] = *(const u32x4*)(ar + 8); }
            __builtin_amdgcn_sched_barrier(0);
#pragma unroll
            for (int i = 0; i < 8; ++i) { float t = 0.f;
#pragma unroll
                for (int j = 0; j < 4; ++j) { t += bflo(a0[i][j]) * bflo(b0[j]) + bfhi(a0[i][j]) * bfhi(b0[j]); t += bflo(a1[i][j]) * bflo(b1[j]) + bfhi(a1[i][j]) * bfhi(b1[j]); }
                s[i] = t; }
#pragma unroll
            for (int o = 1; o < 64; o <<= 1) {
#pragma unroll
                for (int i = 0; i < 8; ++i) s[i] += __shfl_xor(s[i], o); }
            if (F.lane == 0) {
#pragma unroll
                for (int i = 0; i < 8; ++i) F.ZMETA[(size_t)(r0 + i) * DIN + n] = (bf16_t)f2bf(s[i]); }
        }
    }
}

__device__ __forceinline__ unsigned zrow_off(int b, int tp, float& valid) {
    const int tm = tp + NMETA; valid = (tm >= 0) ? 1.0f : 0.0f;
    const unsigned om = (unsigned)WS_ZMETA + (unsigned)(tm > 0 ? (tm < NMETA ? tm : NMETA - 1) : 0) * (unsigned)(DIN * 2);
    const unsigned oz = (unsigned)WS_Z + (unsigned)(b * SEQ + (tp > 0 ? tp : 0)) * (unsigned)(DIN * 2);
    return (tp >= 0) ? oz : om;
}
__device__ __forceinline__ void conformer_tile(Frame& F, int b, int t0) {
    LAS bf16_t* co = (LAS bf16_t*)F.lds;
    LAS float* wl = (LAS float*)(F.lds + 65536);
    const GAS unsigned char* wsg = (const GAS unsigned char*)F.ws;
    const int cp = F.tid & 255, half = F.tid >> 8, c0 = 2 * cp;
    auto cdw = launder(F.in[I_CDW]); auto cdb = launder(F.in[I_CDB]);
    auto lng = launder(F.in[I_CLNG]); auto lnb = launder(F.in[I_CLNB]);
    const f32x4 lg0 = *(const f32x4*)(lng + 8 * F.lane), lg1 = *(const f32x4*)(lng + 8 * F.lane + 4);
    const f32x4 lb0 = *(const f32x4*)(lnb + 8 * F.lane), lb1 = *(const f32x4*)(lnb + 8 * F.lane + 4);
    { f32x4 tw[8];
#pragma unroll
      for (int i = 0; i < 8; ++i) { const int idx = F.tid + i * NTHREADS; tw[i] = *(const f32x4*)(cdw + 4 * (idx < CK * CW / 4 ? idx : 0)); }
#pragma unroll
      for (int i = 0; i < 8; ++i) { const int idx = F.tid + i * NTHREADS; if (idx < CK * CW / 4) *(LAS f32x4*)(wl + 4 * idx) = tw[i]; } }
    const f32x2 cb = *(const f32x2*)(cdb + c0);
    float g0[38], g1[38];
    const int tb = t0 + 32 * half;
    auto row_ld = [&](int tp, unsigned& v, unsigned& g, float& ok) { const unsigned zo = zrow_off(b, tp, ok); v = *(const GAS unsigned*)(wsg + zo + 2 * c0); g = *(const GAS unsigned*)(wsg + zo + 2 * (CW + c0)); };
    auto glu = [&](unsigned v, unsigned g, float ok, float& o0, float& o1) { o0 = ok * bflo(v) * sigmoidf_(bflo(g)); o1 = ok * bfhi(v) * sigmoidf_(bfhi(g)); };
#pragma unroll
    for (int i0 = 0; i0 < 30; i0 += 15) {
        unsigned rv[15], rg[15]; float rk[15];
#pragma unroll
        for (int i = 0; i < 15; ++i) row_ld(tb - 30 + i0 + i, rv[i], rg[i], rk[i]);
        __builtin_amdgcn_sched_barrier(0);
#pragma unroll
        for (int i = 0; i < 15; ++i) glu(rv[i], rg[i], rk[i], g0[i0 + i], g1[i0 + i]);
    }
    unsigned nv[8], ng[8]; float nk[8];
#pragma unroll
    for (int i = 0; i < 8; ++i) row_ld(tb + i, nv[i], ng[i], nk[i]);
    __syncthreads();
#pragma unroll 1
    for (int run = 0; run < 4; ++run) {
        const int ts = tb + 8 * run;
#pragma unroll
        for (int i = 0; i < 8; ++i) glu(nv[i], ng[i], nk[i], g0[30 + i], g1[30 + i]);
        if (run < 3) {
#pragma unroll
            for (int i = 0; i < 8; ++i) row_ld(ts + 8 + i, nv[i], ng[i], nk[i]); }
        __builtin_amdgcn_sched_barrier(0);
        float a0[8], a1[8];
#pragma unroll
        for (int o = 0; o < 8; ++o) { a0[o] = cb[0]; a1[o] = cb[1]; }
#pragma unroll
        for (int k = 0; k < CK; ++k) { const f32x2 w = *(const LAS f32x2*)(wl + k * CW + c0);
#pragma unroll
            for (int o = 0; o < 8; ++o) { a0[o] += w[0] * g0[o + k]; a1[o] += w[1] * g1[o + k]; } }
#pragma unroll
        for (int o = 0; o < 8; ++o) *(LAS unsigned*)(co + (ts - t0 + o) * CW + c0) = pk2(a0[o], a1[o]);
#pragma unroll
        for (int i = 0; i < 30; ++i) { g0[i] = g0[i + 8]; g1[i] = g1[i + 8]; }
    }
    __syncthreads();
#pragma unroll 1
    for (int i0 = 0; i0 < 8; i0 += 4) {
        f32x4 v0[4], v1[4]; float mean[4], var[4];
#pragma unroll
        for (int i = 0; i < 4; ++i) { const int tl = F.wave * 8 + i0 + i; const u32x4 cv = *(const LAS u32x4*)(co + tl * CW + 8 * F.lane);
            v0[i] = (f32x4){bflo(cv[0]), bfhi(cv[0]), bflo(cv[1]), bfhi(cv[1])}; v1[i] = (f32x4){bflo(cv[2]), bfhi(cv[2]), bflo(cv[3]), bfhi(cv[3])};
            mean[i] = (v0[i][0] + v0[i][1]) + (v0[i][2] + v0[i][3]) + (v1[i][0] + v1[i][1]) + (v1[i][2] + v1[i][3]); }
#pragma unroll
        for (int o = 1; o < 64; o <<= 1) {
#pragma unroll
            for (int i = 0; i < 4; ++i) mean[i] += __shfl_xor(mean[i], o); }
#pragma unroll
        for (int i = 0; i < 4; ++i) { mean[i] *= (1.0f / CW); v0[i] = v0[i] - mean[i]; v1[i] = v1[i] - mean[i];
            var[i] = (v0[i][0] * v0[i][0] + v0[i][1] * v0[i][1]) + (v0[i][2] * v0[i][2] + v0[i][3] * v0[i][3]) + (v1[i][0] * v1[i][0] + v1[i][1] * v1[i][1]) + (v1[i][2] * v1[i][2] + v1[i][3] * v1[i][3]); }
#pragma unroll
        for (int o = 1; o < 64; o <<= 1) {
#pragma unroll
            for (int i = 0; i < 4; ++i) var[i] += __shfl_xor(var[i], o); }
#pragma unroll
        for (int i = 0; i < 4; ++i) { const int tl = F.wave * 8 + i0 + i; const float rstd = __builtin_amdgcn_rsqf(var[i] * (1.0f / CW) + LN_EPS);
            float y[8];
#pragma unroll
            for (int j = 0; j < 4; ++j) { y[j] = v0[i][j] * rstd * lg0[j] + lb0[j]; y[4 + j] = v1[i][j] * rstd * lg1[j] + lb1[j]; }
#pragma unroll
            for (int j = 0; j < 8; ++j) y[j] = y[j] * sigmoidf_(y[j]);
            u32x4 o; o.x = pk2(y[0], y[1]); o.y = pk2(y[2], y[3]); o.z = pk2(y[4], y[5]); o.w = pk2(y[6], y[7]);
            *(u32x4*)(F.MIX + ((size_t)b * SEQ + t0 + tl) * D + 8 * F.lane) = o; }
    }
    __syncthreads();
}
constexpr int XC_STRIDE = 520;
constexpr int LDS_XC = 0, LDS_AB = 64 * XC_STRIDE * 2, LDS_CARRY = LDS_AB + NWAVES * 8192;
template <bool FINAL>
__device__ __forceinline__ void lru_tile(Frame& F, int b, int t0, int first_valid, int start_tp, float* sa, float* sh) {
    LAS bf16_t* xc = (LAS bf16_t*)(F.lds + LDS_XC);
    const GAS unsigned char* wsg = (const GAS unsigned char*)F.ws;
    const int h = F.wave, lane = F.lane, q = lane >> 4, c16 = lane & 15;
    LAS f32x2* ab = (LAS f32x2*)(F.lds + LDS_AB + h * 8192);
    bf16x8 Ba[4][2], Bx[4][2];
    auto wat = launder(F.WaT); auto wxt = launder(F.WxT);
#pragma unroll
    for (int n = 0; n < 4; ++n)
#pragma unroll
        for (int ks = 0; ks < 2; ++ks) {
            Ba[n][ks] = *(const GAS bf16x8*)(wat + ((size_t)h * HD + n * 16 + c16) * HD + ks * 32 + 8 * q);
            Bx[n][ks] = *(const GAS bf16x8*)(wxt + ((size_t)h * HD + n * 16 + c16) * HD + ks * 32 + 8 * q);
        }
    float bav[4], bxv[4], lamv[4];
    auto pba = launder(F.in[I_BA]); auto pbx = launder(F.in[I_BX]); auto plam = launder(F.in[I_LAM]);
#pragma unroll
    for (int n = 0; n < 4; ++n) { const int ch = h * HD + n * 16 + c16; bav[n] = pba[ch]; bxv[n] = pbx[ch]; lamv[n] = plam[ch]; }
    {
        const int cp = F.tid & 255, half = F.tid >> 8, c0 = 2 * cp;
        float w0[4], w1[4];
#pragma unroll
        for (int k = 0; k < 4; ++k) { const f32x2 w = *(const f32x2*)(launder(F.in[I_LCW]) + k * LW + c0); w0[k] = w[0]; w1[k] = w[1]; }
        const f32x2 cb = *(const f32x2*)(launder(F.in[I_LCB]) + c0);
        const int tb = t0 + 32 * half;
        int o0 = first_valid - tb; o0 = o0 < 0 ? 0 : (o0 > 32 ? 32 : o0); o0 &= ~15;
        float x0[3], x1[3];
        auto rx_ld = [&](int tp, unsigned& v, float& ok) { const unsigned zo = zrow_off(b, tp, ok); v = *(const GAS unsigned*)(wsg + zo + 2 * (2 * CW + c0)); };
        if (o0 < 32) {
            { unsigned hv[3]; float hk[3];
#pragma unroll
              for (int i = 0; i < 3; ++i) rx_ld(tb + o0 - 3 + i, hv[i], hk[i]);
#pragma unroll
              for (int i = 0; i < 3; ++i) { x0[i] = hk[i] * bflo(hv[i]); x1[i] = hk[i] * bfhi(hv[i]); } }
#pragma unroll 1
            for (int ob = o0; ob < 32; ob += 16) {
                unsigned rv[16]; float rk[16];
#pragma unroll
                for (int i = 0; i < 16; ++i) rx_ld(tb + ob + i, rv[i], rk[i]);
                __builtin_amdgcn_sched_barrier(0);
#pragma unroll
                for (int i = 0; i < 16; ++i) {
                    const float n0 = rk[i] * bflo(rv[i]), n1 = rk[i] * bfhi(rv[i]);
                    const float a0 = cb[0] + w0[0] * x0[0] + w0[1] * x0[1] + w0[2] * x0[2] + w0[3] * n0;
                    const float a1 = cb[1] + w1[0] * x1[0] + w1[1] * x1[1] + w1[2] * x1[2] + w1[3] * n1;
                    *(LAS unsigned*)(xc + (32 * half + ob + i) * XC_STRIDE + c0) = pk2(a0, a1);
                    x0[0] = x0[1]; x0[1] = x0[2]; x0[2] = n0; x1[0] = x1[1]; x1[1] = x1[2]; x1[2] = n1;
                }
            }
        }
    }
    __syncthreads();
    float spv[4];
#pragma unroll
    for (int n = 0; n < 4; ++n) { const float nl = -lamv[n]; spv[n] = fmaxf(nl, 0.f) + log1pf(__expf(-fabsf(nl))); }
    const int chl = h * HD + lane;
    float hs = FINAL ? ((const LAS float*)(F.lds + LDS_CARRY))[chl] : 0.f, aprod = 1.f;
    for (int mt = 0; mt < 4; ++mt) {
        if (t0 + mt * 16 + 15 < first_valid) continue;
        f32x4 accR[4], accI[4];
#pragma unroll
        for (int n = 0; n < 4; ++n) { accR[n] = (f32x4){0.f, 0.f, 0.f, 0.f}; accI[n] = (f32x4){0.f, 0.f, 0.f, 0.f}; }
#pragma unroll
        for (int ks = 0; ks < 2; ++ks) {
            const bf16x8 A = *(const LAS bf16x8*)(xc + (mt * 16 + c16) * XC_STRIDE + h * HD + ks * 32 + 8 * q);
#pragma unroll
            for (int n = 0; n < 4; ++n) { accR[n] = __builtin_amdgcn_mfma_f32_16x16x32_bf16(A, Ba[n][ks], accR[n], 0, 0, 0); accI[n] = __builtin_amdgcn_mfma_f32_16x16x32_bf16(A, Bx[n][ks], accI[n], 0, 0, 0); }
        }
#pragma unroll
        for (int n = 0; n < 4; ++n)
#pragma unroll
            for (int r = 0; r < 4; ++r) {
                const int tl = mt * 16 + 4 * q + r;
                const float rg = sigmoidf_(accR[n][r] + bav[n]), ig = sigmoidf_(accI[n][r] + bxv[n]);
                const float la = -8.0f * rg * spv[n];
                const float a = __expf(la);
                const float om = fmaxf(fmaf(-a, a, 1.0f), 0.0f);
                float mult = __builtin_amdgcn_sqrtf(om);
                if (t0 + tl == start_tp) mult = 1.0f;
                const float xv = bf2f(xc[tl * XC_STRIDE + h * HD + n * 16 + c16]);
                ab[(4 * q + r) * 64 + n * 16 + c16] = (f32x2){a, mult * ig * xv};
            }
        float gv[16];
        if (FINAL) {
#pragma unroll
            for (int i = 0; i < 16; ++i) gv[i] = bf2f(F.Z[((size_t)b * SEQ + t0 + mt * 16 + i) * DIN + 3 * CW + chl]);
        }
        asm volatile("s_waitcnt lgkmcnt(0)" ::: "memory");
#pragma unroll
        for (int i = 0; i < 16; ++i) {
            const f32x2 v = ab[i * 64 + lane];
            if (t0 + mt * 16 + i >= first_valid) { hs = v[0] * hs + v[1]; aprod *= v[0]; }
            if (!FINAL && t0 >= 0) ((unsigned*)(F.ws + WS_AB))[((size_t)b * SEQ + t0 + mt * 16 + i) * LW + chl] = pk2(1.0f - v[0], v[1]);
            if (FINAL) F.MIX[((size_t)b * SEQ + t0 + mt * 16 + i) * D + CW + chl] = (bf16_t)f2bf(hs * gelu_tanh(gv[i]));
        }
        asm volatile("s_waitcnt lgkmcnt(0)" ::: "memory");
    }
    if (!FINAL) { sa[chl] = aprod; sh[chl] = hs; }
    __syncthreads();
}

__device__ __forceinline__ void p5_route_tile(Frame& F, int r0) {
    LAS float* atile = (LAS float*)(F.lds + F.wave * 4352);
    LAS float* plog = (LAS float*)(F.lds + 36864);
    LAS float* rstd_s = (LAS float*)(F.lds + 36864 + 16384);
    LAS int* sel_e = (LAS int*)(F.lds + 36864 + 16384 + 256);
    LAS float* sel_w = (LAS float*)(F.lds + 36864 + 16384 + 256 + 1024);
    LAS int* rank_s = (LAS int*)(F.lds + 36864 + 16384 + 256 + 2048);
    LAS int* lhist = (LAS int*)(F.lds + 36864 + 16384 + 256 + 3072);
    LAS int* lbase = (LAS int*)(F.lds + 36864 + 16384 + 256 + 3072 + 128);
    if (F.tid < NE) lhist[F.tid] = 0;
    {
        f32x4 gv[4];
#pragma unroll
        for (int j = 0; j < 4; ++j) gv[j] = *(const f32x4*)(F.in[I_GFFN] + 4 * F.lane + 256 * j);
#pragma unroll 1
        for (int hb = 0; hb < 2; ++hb) {
            f32x4 v[4][4]; float ss[4]; u32x2 hraw[4][4];
#pragma unroll
            for (int i = 0; i < 4; ++i)
#pragma unroll
                for (int j = 0; j < 4; ++j) hraw[i][j] = *(const u32x2*)(F.H1 + (size_t)(r0 + F.wave * 8 + hb * 4 + i) * D + 4 * F.lane + 256 * j);
            __builtin_amdgcn_sched_barrier(0);
#pragma unroll
            for (int i = 0; i < 4; ++i)
#pragma unroll
                for (int j = 0; j < 4; ++j) v[i][j] = (f32x4){bflo(hraw[i][j].x), bfhi(hraw[i][j].x), bflo(hraw[i][j].y), bfhi(hraw[i][j].y)};
#pragma unroll
            for (int i = 0; i < 4; ++i) { float s = 0.f;
#pragma unroll
                for (int j = 0; j < 4; ++j) s += (v[i][j][0] * v[i][j][0] + v[i][j][1] * v[i][j][1]) + (v[i][j][2] * v[i][j][2] + v[i][j][3] * v[i][j][3]);
                ss[i] = s; }
#pragma unroll
            for (int o = 1; o < 64; o <<= 1) {
#pragma unroll
                for (int i = 0; i < 4; ++i) ss[i] += __shfl_xor(ss[i], o); }
#pragma unroll
            for (int i = 0; i < 4; ++i) { const int rl = F.wave * 8 + hb * 4 + i; const float rstd = 1.0f / sqrtf(ss[i] * (1.0f / D) + NORM_EPS);
                if (F.lane == 0) rstd_s[rl] = rstd;
                const float sc = rstd * A8_SCALE;
#pragma unroll
                for (int j = 0; j < 4; ++j) *(unsigned*)(F.U1 + (size_t)(r0 + rl) * D + 4 * F.lane + 256 * j) = pk4_fp8(v[i][j][0] * sc * gv[j][0], v[i][j][1] * sc * gv[j][1], v[i][j][2] * sc * gv[j][2], v[i][j][3] * sc * gv[j][3]); }
        }
    }
    {
        const int mt = F.wave & 3, kh = F.wave >> 2, lane = F.lane, q = lane >> 4, c16 = lane & 15;
        f32x4 acc0 = (f32x4){0.f, 0.f, 0.f, 0.f}, acc1 = (f32x4){0.f, 0.f, 0.f, 0.f};
        const bf16_t* arow = F.H1 + (size_t)(r0 + mt * 16 + c16) * D + kh * 512 + 8 * q;
        const bf16_t* wr = (const bf16_t*)F.WR + (size_t)c16 * D + kh * 512 + 8 * q;
#pragma unroll 1
        for (int s0 = 0; s0 < 16; s0 += 4) {
            bf16x8 af[4], bh0[4], bh1[4], bl0[4], bl1[4];
#pragma unroll
            for (int s = 0; s < 4; ++s) { const int ko = 32 * (s0 + s);
                af[s] = *(const bf16x8*)(arow + ko);
                bh0[s] = *(const bf16x8*)(wr + ko); bh1[s] = *(const bf16x8*)(wr + 16 * D + ko);
                bl0[s] = *(const bf16x8*)(wr + NE * D + ko); bl1[s] = *(const bf16x8*)(wr + NE * D + 16 * D + ko); }
            __builtin_amdgcn_sched_barrier(0);
#pragma unroll
            for (int s = 0; s < 4; ++s) {
                acc0 = __builtin_amdgcn_mfma_f32_16x16x32_bf16(af[s], bh0[s], acc0, 0, 0, 0); acc0 = __builtin_amdgcn_mfma_f32_16x16x32_bf16(af[s], bl0[s], acc0, 0, 0, 0);
                acc1 = __builtin_amdgcn_mfma_f32_16x16x32_bf16(af[s], bh1[s], acc1, 0, 0, 0); acc1 = __builtin_amdgcn_mfma_f32_16x16x32_bf16(af[s], bl1[s], acc1, 0, 0, 0);
            }
        }
#pragma unroll
        for (int r = 0; r < 4; ++r) { plog[(kh * 64 + mt * 16 + 4 * q + r) * NE + c16] = acc0[r]; plog[(kh * 64 + mt * 16 + 4 * q + r) * NE + 16 + c16] = acc1[r]; }
    }
    __syncthreads();
    if (F.tid < 64) {
        const int t = F.tid; const float rs = rstd_s[t];
        float b0 = -3.0e38f, b1 = -3.0e38f, b2 = -3.0e38f, b3 = -3.0e38f; int i0 = 0, i1 = 0, i2 = 0, i3 = 0;
        for (int e = 0; e < NE; ++e) {
            const float v = (plog[t * NE + e] + plog[(64 + t) * NE + e]) * rs + F.in[I_BROUTER][e];
            if (v > b3) {
                if (v > b2) { b3 = b2; i3 = i2;
                    if (v > b1) { b2 = b1; i2 = i1;
                        if (v > b0) { b1 = b0; i1 = i0; b0 = v; i0 = e; } else { b1 = v; i1 = e; }
                    } else { b2 = v; i2 = e; }
                } else { b3 = v; i3 = e; }
            }
        }
        const float e0 = 1.0f, e1 = __expf(b1 - b0), e2 = __expf(b2 - b0), e3 = __expf(b3 - b0);
        const float inv = 1.0f / (e0 + e1 + e2 + e3);
        sel_e[t * 4 + 0] = i0; sel_e[t * 4 + 1] = i1; sel_e[t * 4 + 2] = i2; sel_e[t * 4 + 3] = i3;
        sel_w[t * 4 + 0] = e0 * inv; sel_w[t * 4 + 1] = e1 * inv; sel_w[t * 4 + 2] = e2 * inv; sel_w[t * 4 + 3] = e3 * inv;
    }
    __syncthreads();
    LAS int* wcnt = rank_s;
    int se = 0, rk = 0;
    if (F.tid < 256) {
        se = sel_e[F.tid]; unsigned long long mine = 0ull; int cnt_e = 0;
        for (int e = 0; e < NE; ++e) { const unsigned long long m = __ballot(se == e); if (se == e) mine = m; if (F.lane == e) cnt_e = __popcll(m); }
        rk = __popcll(mine & ((1ull << F.lane) - 1ull));
        if (F.lane < NE) wcnt[F.wave * NE + F.lane] = cnt_e;
    }
    __syncthreads();
    if (F.tid < 256) { for (int w = 0; w < F.wave; ++w) rk += wcnt[w * NE + se];
        const int pair = r0 * 4 + F.tid; ((int*)(F.ws + WS_PINFO))[pair] = se | (rk << 8); F.GATEW[pair] = sel_w[F.tid]; }
    if (F.tid < NE) ((int*)(F.ws + WS_HIST))[(r0 / 64) * NE + F.tid] = wcnt[F.tid] + wcnt[NE + F.tid] + wcnt[2 * NE + F.tid] + wcnt[3 * NE + F.tid];
    __syncthreads();
}

__device__ __forceinline__ void p5b_lists(Frame& F) {
    LAS int* part = (LAS int*)F.lds;
    const int* hist = (const int*)(F.ws + WS_HIST); const int* pinfo = (const int*)(F.ws + WS_PINFO);
    for (int blk = F.vcu; blk < NTOK / 64; blk += F.G) {
        { const int e = F.tid & 31, pt = F.tid >> 5; int sum = 0;
#pragma unroll
          for (int i = 0; i < 16; ++i) { const int b = pt + 16 * i; const int v = hist[b * NE + e]; sum += (b < blk) ? v : 0; }
          part[pt * NE + e] = sum; }
        __syncthreads();
        if (F.tid < NE) { int sum = 0; for (int pt = 0; pt < 16; ++pt) sum += part[pt * NE + F.tid]; part[512 + F.tid] = sum; }
        __syncthreads();
        if (F.tid < 256) { const int pair = blk * 256 + F.tid, info = pinfo[pair], e = info & 255, rk = info >> 8; const size_t pos = (size_t)e * NTOK + part[512 + e] + rk; F.LIST[pos] = pair; ((float*)(F.ws + WS_LISTG))[pos] = F.GATEW[pair]; }
        __syncthreads();
    }
}

__device__ __forceinline__ MoeSched moe_sched_build(Frame& F) {
    LAS int* cnt = (LAS int*)(F.lds + LDS_TAB); LAS int* tbase = cnt + 64;
    __syncthreads();
    { LAS int* part = cnt + 128; const int* hist = (const int*)(F.ws + WS_HIST); const int e = F.tid & 31, pt = F.tid >> 5; int sum = 0;
#pragma unroll
      for (int i = 0; i < 16; ++i) sum += hist[(pt + 16 * i) * NE + e];
      part[pt * NE + e] = sum; }
    __syncthreads();
    if (F.tid < NE) { int sum = 0; for (int pt = 0; pt < 16; ++pt) sum += cnt[128 + pt * NE + F.tid]; cnt[F.tid] = sum; }
    __syncthreads();
    if (F.tid == 0) { int s = 0; for (int e = 0; e < NE; ++e) { tbase[e] = s; s += (cnt[e] + BM - 1) / BM; } tbase[NE] = s; }
    __syncthreads();
    MoeSched M; M.cnt = cnt; M.tbase = tbase; M.G = F.G; M.vcu = F.vcu; return M;
}

__device__ __forceinline__ void p8_final(Frame& F) {
    f32x4 g0[2], g1[2];
#pragma unroll
    for (int hf = 0; hf < 2; ++hf) { const int k0 = hf * 512 + 8 * F.lane; g0[hf] = *(const f32x4*)(F.in[I_GFINAL] + k0); g1[hf] = *(const f32x4*)(F.in[I_GFINAL] + k0 + 4); }
#pragma unroll 1
    for (int m0 = F.gw; m0 < NTOK; m0 += 2 * F.NGW) {
        f32x4 ha[2][2], hb[2][2]; u32x2 yy[2][2][TOPK];
#pragma unroll
        for (int rr = 0; rr < 2; ++rr) { size_t m = (size_t)m0 + (size_t)rr * F.NGW; m = m < (size_t)NTOK ? m : (size_t)m0;
#pragma unroll
            for (int hf = 0; hf < 2; ++hf) { const int k0 = hf * 512 + 8 * F.lane;
                { const u32x4 hv = *(const u32x4*)(F.H1 + m * D + k0); ha[rr][hf] = (f32x4){bflo(hv[0]), bfhi(hv[0]), bflo(hv[1]), bfhi(hv[1])}; hb[rr][hf] = (f32x4){bflo(hv[2]), bfhi(hv[2]), bflo(hv[3]), bfhi(hv[3])}; }
#pragma unroll
                for (int k = 0; k < TOPK; ++k) yy[rr][hf][k] = *(const u32x2*)(F.Y + (m * TOPK + k) * D + k0); } }
        __builtin_amdgcn_sched_barrier(0);
#pragma unroll
        for (int rr = 0; rr < 2; ++rr) { const size_t m = (size_t)m0 + (size_t)rr * F.NGW; if (m >= (size_t)NTOK) continue;
            float v[16];
#pragma unroll
            for (int hf = 0; hf < 2; ++hf) {
                float acc8[8] = {0.f, 0.f, 0.f, 0.f, 0.f, 0.f, 0.f, 0.f};
#pragma unroll
                for (int k = 0; k < TOPK; ++k) {
                    const f32x2 p0 = __builtin_amdgcn_cvt_pk_f32_fp8((int)yy[rr][hf][k].x, false), p1 = __builtin_amdgcn_cvt_pk_f32_fp8((int)yy[rr][hf][k].x, true);
                    const f32x2 p2 = __builtin_amdgcn_cvt_pk_f32_fp8((int)yy[rr][hf][k].y, false), p3 = __builtin_amdgcn_cvt_pk_f32_fp8((int)yy[rr][hf][k].y, true);
                    acc8[0] += p0[0]; acc8[1] += p0[1]; acc8[2] += p1[0]; acc8[3] += p1[1]; acc8[4] += p2[0]; acc8[5] += p2[1]; acc8[6] += p3[0]; acc8[7] += p3[1]; }
#pragma unroll
                for (int j = 0; j < 4; ++j) { v[hf * 8 + j] = ha[rr][hf][j] + acc8[j] * (1.0f / Y8_SCALE); v[hf * 8 + 4 + j] = hb[rr][hf][j] + acc8[4 + j] * (1.0f / Y8_SCALE); }
            }
            float s = 0.f;
#pragma unroll
            for (int j = 0; j < 16; ++j) s += v[j] * v[j];
            const float rstd = 1.0f / sqrtf(wave_sum(s) * (1.0f / D) + NORM_EPS);
#pragma unroll
            for (int hf = 0; hf < 2; ++hf) { const int k0 = hf * 512 + 8 * F.lane;
                f32x4 o0, o1;
#pragma unroll
                for (int j = 0; j < 4; ++j) { o0[j] = v[hf * 8 + j] * rstd * g0[hf][j]; o1[j] = v[hf * 8 + 4 + j] * rstd * g1[hf][j]; }
                *(f32x4*)(F.out + m * D + k0) = o0; *(f32x4*)(F.out + m * D + k0 + 4) = o1; }
        }
    }
}

__device__ __forceinline__ void naive_p1(Frame& F) {
    for (long o = F.gw; o < (long)NTOK * DIN; o += F.NGW) { const int r = (int)(o / DIN), n = (int)(o % DIN);
        const float s = wave_dot_bf16(F.U0 + (size_t)r * D, F.WinT + (size_t)n * D, F.lane); if (F.lane == 0) F.Z[o] = (bf16_t)f2bf(s); }
}
__device__ __forceinline__ void naive_p4(Frame& F) {
    for (long o = F.gw; o < (long)NTOK * D; o += F.NGW) { const int r = (int)(o / D), n = (int)(o % D);
        const float s = wave_dot_bf16(F.MIX + (size_t)r * D, F.WoutT + (size_t)n * D, F.lane); if (F.lane == 0) F.H1[o] = (bf16_t)f2bf(F.in[I_X][o] + s); }
}

__global__ void __launch_bounds__(NTHREADS, 2) mk_fwd(Params p) {
    extern __shared__ __attribute__((aligned(16))) unsigned char lds_raw[];
    Frame F;
    F.lds = (LAS unsigned char*)lds_raw;
    F.tid = threadIdx.x; F.lane = F.tid & 63; F.wave = __builtin_amdgcn_readfirstlane(F.tid >> 6);
    F.G = gridDim.x; { const int bx = blockIdx.x; F.vcu = (F.G % 8 == 0) ? (bx % 8) * (F.G / 8) + bx / 8 : bx; }
    F.gw = F.vcu * NWAVES + F.wave; F.NGW = F.G * NWAVES;
#pragma unroll
    for (int i = 0; i < 24; ++i) F.in[i] = p.in[i];
    F.out = p.out; F.ws = p.ws; unsigned char* ws = p.ws;
    F.ctl = (unsigned*)(ws + WS_CTL);
    F.WinT = (bf16_t*)(ws + WS_WINT); F.WoutT = (bf16_t*)(ws + WS_WOUTT); F.WaT = (bf16_t*)(ws + WS_WAT); F.WxT = (bf16_t*)(ws + WS_WXT);
    F.WR = (float*)(ws + WS_WR); F.UMETA = (bf16_t*)(ws + WS_UMETA); F.ZMETA = (bf16_t*)(ws + WS_ZMETA); F.HMETA = (float*)(ws + WS_HMETA);
    F.SUMM = (float*)(ws + WS_SUMM); F.LIST = (int*)(ws + WS_LIST); F.GATEW = (float*)(ws + WS_GATEW);
    F.WguT = (fp8_t*)(ws + WS_WGUT); F.WdT = (fp8_t*)(ws + WS_WDT); F.U0 = (bf16_t*)(ws + WS_U0); F.Z = (bf16_t*)(ws + WS_Z);
    F.MIX = (bf16_t*)(ws + WS_MIX); F.H1 = (bf16_t*)(ws + WS_H1); F.U1 = (fp8_t*)(ws + WS_U1); F.ACT = (fp8_t*)(ws + WS_ACT); F.Y = (fp8_t*)(ws + WS_Y);

    volatile LAS unsigned* barw = (volatile LAS unsigned*)(F.lds + LDS_BARW);
    if (F.tid < 4) barw[F.tid] = 0u;
    __syncthreads();
    XcdBarrier bar; bar.bar = F.ctl + CW_BAR; bar.x = 0; bar.st = nullptr;
    if (MK_N_LAUNCHES == 1) bar = xcd_barrier_post(F.ctl + CW_BAR, barw);
    const int lo = p.ph_lo, hi = p.ph_hi;
#define IN(k) (((PH_MASK >> (k)) & 1) && lo <= (k) && (k) < hi)
#define SEAM(k) do { if (IN(k) && IN((k) + 1)) xcd_barrier(bar); } while (0)

    if (IN(0)) { p0_prologue(F); }
    SEAM(0);
    if (IN(1)) {
        if (NAIVE_MASK & 2) naive_p1(F);
        else { ProbIn P{F.U0, F.WinT, F.Z, F.G, (int)blockIdx.x}; gemm_phase<ProbIn, false>(F.lds, P); }
        p1_zmeta(F);
    }
    SEAM(1);
    if (IN(2)) {
        for (int it = F.vcu; it < NB * NTILE + 1; it += F.G) {
            if (it < NB * NTILE) {
                const int b = it / NTILE, j = it % NTILE;
#ifndef NO_CONF
                conformer_tile(F, b, j * TT);
                if (DBL_MASK & 1) conformer_tile(F, b, j * TT);
#endif
#ifndef NO_LRU
                float* s = F.SUMM + ((size_t)(b * NTILE + j) * 2) * LW;
                lru_tile<false>(F, b, j * TT, -1000000, -1000000, s, s + LW);
                if (DBL_MASK & 2) lru_tile<false>(F, b, j * TT, -1000000, -1000000, s, s + LW);
#endif
            } else {
#ifndef NO_LRU
                lru_tile<false>(F, 0, -TT, -NMETA, -NMETA, F.HMETA + LW, F.HMETA);
                if (DBL_MASK & 4) lru_tile<false>(F, 0, -TT, -NMETA, -NMETA, F.HMETA + LW, F.HMETA);
#endif
            }
        }
    }
    SEAM(2);
    if (IN(3)) {
        for (int it = F.vcu; it < NB * NTILE; it += F.G) {
            const int b = it / NTILE, j = it % NTILE, c = F.tid;
            float hc = F.HMETA[c];
            const size_t row0 = (size_t)b * SEQ + (size_t)j * TT;
            const unsigned* abp = (const unsigned*)(F.ws + WS_AB) + row0 * LW + c;
            const bf16_t* gp = F.Z + row0 * DIN + 3 * CW + c;
            bf16_t* mp = F.MIX + row0 * D + CW + c;
            unsigned ab[16]; unsigned short gr[16];
#pragma unroll
            for (int i = 0; i < 16; ++i) { ab[i] = abp[(size_t)i * LW]; gr[i] = gp[(size_t)i * DIN]; }
            { const float* sb = F.SUMM + ((size_t)b * NTILE * 2) * LW + c;
              int jj = 0;
              for (; jj + 8 <= j; jj += 8) { float av[8], hv[8];
#pragma unroll
                  for (int u = 0; u < 8; ++u) { av[u] = sb[(size_t)(jj + u) * 2 * LW]; hv[u] = sb[(size_t)(jj + u) * 2 * LW + LW]; }
#pragma unroll
                  for (int u = 0; u < 8; ++u) hc = av[u] * hc + hv[u]; }
              for (; jj < j; ++jj) hc = sb[(size_t)jj * 2 * LW] * hc + sb[(size_t)jj * 2 * LW + LW]; }
#pragma unroll 1
            for (int t0 = 0; t0 < TT; t0 += 16) {
                unsigned nab[16]; unsigned short ngr[16];
                if (t0 + 16 < TT) {
#pragma unroll
                    for (int i = 0; i < 16; ++i) { nab[i] = abp[(size_t)(t0 + 16 + i) * LW]; ngr[i] = gp[(size_t)(t0 + 16 + i) * DIN]; } }
                __builtin_amdgcn_sched_barrier(0);
#pragma unroll
                for (int i = 0; i < 16; ++i) { hc = (1.0f - bflo(ab[i])) * hc + bfhi(ab[i]); mp[(size_t)(t0 + i) * D] = (bf16_t)f2bf(hc * gelu_tanh(bf2f(gr[i]))); }
#pragma unroll
                for (int i = 0; i < 16; ++i) { ab[i] = nab[i]; gr[i] = ngr[i]; }
            }
        }
    }
    SEAM(3);
    if (IN(4)) {
        if (NAIVE_MASK & 16) naive_p4(F);
        else { ProbOut P{F.MIX, F.WoutT, F.in[I_X], F.H1, F.G, (int)blockIdx.x}; gemm_phase<ProbOut, false>(F.lds, P); }
    }
    SEAM(4);
    if (IN(5)) {
        constexpr int NITEM = NE * (D / 64) * (DIN / 64) + NE * (D / 64) * (D / 64);
        if ((F.G & 1) == 0) {
            const int np = F.G >> 1, pr = F.vcu >> 1, nvw = np * NWAVES, rounds = (NITEM + nvw - 1) / nvw, ks = (rounds * CONV_SPLIT + 12) / 24;
            int k_lo = 0, k_hi = ks;
            if (F.vcu & 1) { for (int it = pr; it < NTOK / 64; it += np) p5_route_tile(F, it * 64); k_lo = ks; k_hi = rounds; }
            expert_weights_to_fp8(F, pr * NWAVES + F.wave, nvw, k_lo, k_hi);
        } else {
            for (int it = F.vcu; it < NTOK / 64; it += F.G) p5_route_tile(F, it * 64);
            expert_weights_to_fp8(F, F.gw, F.NGW, 0, (NITEM + F.NGW - 1) / F.NGW);
        }
    }
    SEAM(5);
    if (IN(6)) { p5b_lists(F); }
    SEAM(6);
    if (IN(7)) {
        const MoeSched M = moe_sched_build(F);
        { ProbGU P{F.U1, F.WguT, F.in[I_BGU], F.LIST, F.ACT, M}; gemm_phase<ProbGU, true>(F.lds, P); }
    }
    SEAM(7);
    if (IN(8)) {
        MoeSched M;
        if (MK_N_LAUNCHES == 1 && IN(7)) { LAS int* cnt = (LAS int*)(F.lds + LDS_TAB); M.cnt = cnt; M.tbase = cnt + 64; M.G = F.G; M.vcu = F.vcu; }
        else M = moe_sched_build(F);
        { ProbDown P{F.ACT, F.WdT, F.in[I_BD], F.LIST, (const float*)(F.ws + WS_LISTG), F.Y, M}; gemm_phase<ProbDown, true>(F.lds, P); }
    }
    SEAM(8);
    if (IN(9)) p8_final(F);
#undef IN
#undef SEAM
}
}

extern "C" void kernel_launch(void* const* d_in, const int* in_sizes, int n_in, void* d_out, int out_size, void* d_ws, size_t ws_size, hipStream_t stream) {
    using namespace mk;
    static int grid = 0;
    if (grid == 0) {
        if (n_in != 24 || out_size != NTOK * D || ws_size < WS_END) { fprintf(stderr, "kernel_launch: unexpected shapes (n_in %d out %d ws %zu)\n", n_in, out_size, ws_size); grid = -1; return; }
        int dev = 0, cus = 0, per_cu = 0;
        if (hipGetDevice(&dev) != hipSuccess || hipDeviceGetAttribute(&cus, hipDeviceAttributeMultiprocessorCount, dev) != hipSuccess) { grid = -1; return; }
        if (hipFuncSetAttribute((const void*)mk_fwd, hipFuncAttributeMaxDynamicSharedMemorySize, LDS_BYTES) != hipSuccess) { fprintf(stderr, "kernel_launch: hipFuncSetAttribute failed\n"); grid = -1; return; }
        if (hipOccupancyMaxActiveBlocksPerMultiprocessor(&per_cu, (const void*)mk_fwd, NTHREADS, LDS_BYTES) != hipSuccess || per_cu < 1) { fprintf(stderr, "kernel_launch: occupancy query says %d\n", per_cu); grid = -1; return; }
        grid = cus;
    }
    if (grid <= 0) return;
    (void)in_sizes;
    (void)hipMemsetAsync((char*)d_ws + WS_CTL, 0, CTL_ZERO_BYTES, stream);
    Params p{};
    for (int i = 0; i < 24; ++i) p.in[i] = (const float*)d_in[i];
    p.out = (float*)d_out; p.ws = (unsigned char*)d_ws;
    if (MK_N_LAUNCHES == 1) { p.ph_lo = 0; p.ph_hi = 10; hipLaunchKernelGGL(mk_fwd, dim3(grid), dim3(NTHREADS), LDS_BYTES, stream, p); }
    else { for (int ph = 0; ph < 10; ++ph) { p.ph_lo = ph; p.ph_hi = ph + 1;
            for (int rep = 0; rep < 1 + ((REP_MASK >> ph) & 1); ++rep) {
                hipLaunchKernelGGL(mk_fwd, dim3(grid), dim3(NTHREADS), LDS_BYTES, stream, p); } } }
}
```

```cpp
#include <hip/hip_runtime.h>
#include <stdint.h>
#include <stdio.h>

#ifndef MK_N_LAUNCHES
#define MK_N_LAUNCHES 1
#endif
#ifndef PH_MASK
#define PH_MASK 0x3ff
#endif
#ifndef REP_MASK
#define REP_MASK 0
#endif
#ifndef DBL_MASK
#define DBL_MASK 0
#endif
#ifndef NAIVE_MASK
#define CONV_SPLIT 22
#define NAIVE_MASK 0
#endif

#define GAS __attribute__((address_space(1)))
#define LAS __attribute__((address_space(3)))
typedef unsigned short bf16_t;
typedef short bf16x8 __attribute__((ext_vector_type(8)));
typedef float f32x4 __attribute__((ext_vector_type(4)));
typedef float f32x2 __attribute__((ext_vector_type(2)));
typedef unsigned u32x4 __attribute__((ext_vector_type(4)));
typedef unsigned u32x2 __attribute__((ext_vector_type(2)));
typedef int i32x4 __attribute__((ext_vector_type(4)));
typedef int i32x8 __attribute__((ext_vector_type(8)));
typedef unsigned char fp8_t;

namespace mk {
constexpr int D = 1024, NB = 4, SEQ = 4096, NTOK = NB * SEQ, NMETA = 16;
constexpr int CW = 512, LW = 512, DIN = 2048, CK = 31, NE = 32, TOPK = 4, NH = 8, HD = 64;
constexpr int NPAIR = NTOK * TOPK;
constexpr int ACT_ROWS = NPAIR + NE * 256;
constexpr int NTHREADS = 512, NWAVES = 8;
constexpr int TT = 64;
constexpr int NTILE = SEQ / TT;
constexpr float NORM_EPS = 1e-6f, LN_EPS = 1e-5f;

constexpr size_t MiB = 1u << 20, KiB = 1u << 10;
constexpr size_t WS_CTL = 0, CTL_ZERO_BYTES = 64 * KiB;
constexpr size_t WS_WINT = 1 * MiB;
constexpr size_t WS_WOUTT = 5 * MiB;
constexpr size_t WS_WAT = 7 * MiB;
constexpr size_t WS_WXT = 7 * MiB + 64 * KiB;
constexpr size_t WS_WR = 7 * MiB + 128 * KiB;
constexpr size_t WS_UMETA = 7 * MiB + 256 * KiB;
constexpr size_t WS_ZMETA = 7 * MiB + 320 * KiB;
constexpr size_t WS_HMETA = 7 * MiB + 384 * KiB;
constexpr size_t WS_SUMM = 8 * MiB;
constexpr size_t WS_LIST = 9 * MiB;
constexpr size_t WS_GATEW = 11 * MiB;
constexpr size_t WS_HIST = 11 * MiB + 512 * KiB;
constexpr size_t WS_LISTG = 13 * MiB;
constexpr size_t WS_PINFO = 12 * MiB;
constexpr size_t WS_WGUT = 16 * MiB;
constexpr size_t WS_WDT = 144 * MiB;
constexpr size_t WS_U0 = 208 * MiB;
constexpr size_t WS_Z = 240 * MiB;
constexpr size_t WS_MIX = 304 * MiB;
constexpr size_t WS_H1 = 336 * MiB;
constexpr size_t WS_U1 = 400 * MiB;
constexpr size_t WS_ACT = 432 * MiB;
constexpr size_t WS_Y = 576 * MiB;
constexpr size_t WS_AB = 640 * MiB;
constexpr size_t WS_END = 704 * MiB;
constexpr int CW_BAR = 4096;
constexpr int CW_RDONE = 12288;
constexpr int CW_CNT = 8192;

constexpr int LDS_BYTES = 147456;
constexpr int LDS_TAB = 135168;
constexpr int LDS_IDS = 144384;
constexpr int LDS_PF = 138240, PF_BYTES = 3072;
constexpr int LDS_BARW = LDS_BYTES - 64;

__device__ __forceinline__ unsigned f2bf(float f) { unsigned u = __float_as_uint(f); return (u + 0x7fffu + ((u >> 16) & 1u)) >> 16; }
__device__ __forceinline__ float bf2f(unsigned b) { return __uint_as_float(b << 16); }
__device__ __forceinline__ float bflo(unsigned w) { return __uint_as_float(w << 16); }
__device__ __forceinline__ float bfhi(unsigned w) { return __uint_as_float(w & 0xffff0000u); }
__device__ __forceinline__ unsigned pk2(float lo, float hi) { return f2bf(lo) | (f2bf(hi) << 16); }
__device__ __forceinline__ unsigned pk4_fp8(float a, float b, float c, float d) { int w = 0; w = __builtin_amdgcn_cvt_pk_fp8_f32(a, b, w, false); w = __builtin_amdgcn_cvt_pk_fp8_f32(c, d, w, true); return (unsigned)w; }
constexpr float W8_SCALE = 64.0f, A8_SCALE = 4.0f, Y8_SCALE = 16.0f;
constexpr int W8_E8M0 = 0x79797979, A8_E8M0 = 0x7d7d7d7d;
__device__ __forceinline__ float wave_sum(float v) {
#pragma unroll
    for (int o = 1; o < 64; o <<= 1) v += __shfl_xor(v, o);
    return v;
}
__device__ __forceinline__ float sigmoidf_(float x) { return __builtin_amdgcn_rcpf(1.0f + __expf(-x)); }
__device__ __forceinline__ float gelu_tanh(float x) {
    const float u = 0.7978845608028654f * (x + 0.044715f * x * x * x);
    const float t = 1.0f - 2.0f * __builtin_amdgcn_rcpf(1.0f + __expf(2.0f * u));
    return 0.5f * x * (1.0f + t);
}

#define XB_TMO      128
#define XB_XCNT(j)  (256  + 64 * (j))
#define XB_XSUB(j)  (1280 + 64 * (j))
#define XB_XGEN(j)  (2304 + 64 * (j))
#define XB_TOP      3328
#define XB_TOPGEN   3392
#define XCD_BAR_WORDS 3456
#define XB_SPIN_CAP (1u << 18)

__device__ __forceinline__ unsigned xb_ld(unsigned* p)              { return __hip_atomic_load(p, __ATOMIC_RELAXED, __HIP_MEMORY_SCOPE_AGENT); }
__device__ __forceinline__ unsigned xb_add(unsigned* p, unsigned v) { return __hip_atomic_fetch_add(p, v, __ATOMIC_RELAXED, __HIP_MEMORY_SCOPE_AGENT); }
__device__ __forceinline__ unsigned xb_xcc_id() { return (unsigned)__builtin_amdgcn_s_getreg((3 << 11) | 20) & 0xFu; }
#define XB_SPIN(cond, bar) do { unsigned _sp = 0; while (cond) { __builtin_amdgcn_s_sleep(1); \
    if ((++_sp & 255u) == 0u) { if (xb_ld(&(bar)[XB_TMO])) break; if (_sp > XB_SPIN_CAP) { atomicAdd(&(bar)[XB_TMO], 1u); break; } } } } while (0)

struct XcdBarrier {
    unsigned* bar; unsigned x;
    volatile LAS unsigned* st;
};
__device__ __forceinline__ XcdBarrier xcd_barrier_post(unsigned* bar, volatile LAS unsigned* st) {
    XcdBarrier b; b.bar = bar; b.x = xb_xcc_id(); b.st = st;
    if (threadIdx.x == 0) (void)xb_add(&bar[XB_XCNT(b.x)], 1u);
    return b;
}
__device__ __forceinline__ void xcd_barrier_complete(unsigned* bar, unsigned x, unsigned& nloc, unsigned& nx) {
    const unsigned G = gridDim.x * gridDim.y * gridDim.z;
    unsigned sum, cnt, mine, sp = 0u;
    for (;;) {
        sum = 0u; cnt = 0u; mine = 0u;
#pragma unroll
        for (unsigned j = 0; j < 16; ++j) { const unsigned c = xb_ld(&bar[XB_XCNT(j)]); sum += c; cnt += (c > 0u) ? 1u : 0u; mine = (j == x) ? c : mine; }
        if (sum == G) break;
        __builtin_amdgcn_s_sleep(1);
        if ((++sp & 255u) == 0u) { if (xb_ld(&bar[XB_TMO])) break; if (sp > XB_SPIN_CAP) { atomicAdd(&bar[XB_TMO], 1u); break; } }
    }
    nloc = mine > 0u ? mine : 1u; nx = cnt > 0u ? cnt : 1u;
}
__device__ __forceinline__ void xcd_barrier(const XcdBarrier& b) {
    asm volatile("s_waitcnt vmcnt(0)" ::: "memory");
    __syncthreads();
    if (threadIdx.x == 0) {
        unsigned* bar = b.bar;
        __builtin_amdgcn_s_waitcnt(0);
        unsigned nloc = b.st[0], nx = b.st[1];
        if (nloc == 0u) { xcd_barrier_complete(bar, b.x, nloc, nx); b.st[0] = nloc; b.st[1] = nx; }
        const unsigned old = xb_add(&bar[XB_XSUB(b.x)], 1u);
        const unsigned gen = old / nloc;
        if (old + 1u == (gen + 1u) * nloc) {
            __builtin_amdgcn_fence(__ATOMIC_RELEASE, "agent");
            asm volatile("s_waitcnt vmcnt(0)" ::: "memory");
            const unsigned og = xb_add(&bar[XB_TOP], 1u);
            const unsigned tg = og / nx;
            if (og + 1u == (tg + 1u) * nx) xb_add(&bar[XB_TOPGEN], 1u);
            else XB_SPIN(xb_ld(&bar[XB_TOPGEN]) == tg, bar);
            __builtin_amdgcn_fence(__ATOMIC_ACQUIRE, "agent");
            xb_add(&bar[XB_XGEN(b.x)], 1u);
            asm volatile("s_waitcnt vmcnt(0)" ::: "memory");
        } else {
            XB_SPIN(xb_ld(&bar[XB_XGEN(b.x)]) == gen, bar);
            __builtin_amdgcn_fence(__ATOMIC_ACQUIRE, "agent");
            asm volatile("s_waitcnt vmcnt(0)" ::: "memory");
        }
    }
    __syncthreads();
}

struct Params {
    const float* in[24];
    float* out;
    unsigned char* ws;
    int ph_lo, ph_hi;
};
enum { I_X = 0, I_META, I_GMIX, I_WIN, I_CDW, I_CDB, I_CLNG, I_CLNB, I_LCW, I_LCB, I_WA, I_BA, I_WX, I_BX, I_LAM, I_WOUT, I_GFFN, I_WROUTER, I_BROUTER, I_WGU, I_BGU, I_WD, I_BD, I_GFINAL };

constexpr int BM = 256, BK = 64, HALF = 128, HTB = HALF * BK * 2, STAGE_BYTES = 8 * HTB, GK = 1024;
__device__ __forceinline__ int lds_byte(int r, int c) { const int st = (r >> 4) * 2 + (c >> 5), rr = r & 15, cc = c & 31, ob = rr * 64 + cc * 2; return st * 1024 + (ob ^ (((ob >> 9) & 1) << 5)); }
__device__ __forceinline__ void stage_rc(int b, int& R, int& C) { const int st = b / 1024, sb = b % 1024, swz = sb ^ (((sb >> 9) & 1) << 5); R = (st >> 1) * 16 + swz / 64; C = (st & 1) * 32 + (swz % 64) / 2; }
__device__ __forceinline__ int perm32(int rho) { const int n = rho >> 4, i = rho & 15; return 8 * (i >> 2) + 4 * n + (i & 3); }
__device__ __forceinline__ unsigned cvt_pk_bf16(float lo, float hi) { unsigned r; asm volatile("v_cvt_pk_bf16_f32 %0, %1, %2" : "=v"(r) : "v"(lo), "v"(hi)); return r; }

template <class T> __device__ __forceinline__ T* launder(T* p) { asm volatile("" : "+s"(p)); return p; }
struct Unit { int pm, pn, e, rows, rt; };
__device__ __forceinline__ void mfma_fp8_inplace(f32x4& acc, const i32x8& w, const i32x8& x, int sw, int sx) {
    asm volatile("v_mfma_scale_f32_16x16x128_f8f6f4 %0, %1, %2, %0, %3, %4 op_sel_hi:[0,0,0]" : "+v"(acc) : "v"(w), "v"(x), "v"(sw), "v"(sx));
}

template <class P, bool FP8>
__device__ __forceinline__ void gemm_phase(LAS unsigned char* lds, const P& S) {
    const int tid = threadIdx.x, wid = __builtin_amdgcn_readfirstlane(tid >> 6), lane = tid & 63, wr = wid >> 2, wc = wid & 3, fr = lane & 15, fq = lane >> 4;
    constexpr int K = GK, KB = FP8 ? K : 2 * K  , nt = KB / (BK * 2);
    constexpr bool GATHER = P::GATHER;
    unsigned voffB[2], voffA[2], c2 = 0;
#pragma unroll
    for (int i = 0; i < 2; ++i) { int pR, pC; stage_rc(tid * 16 + i * 8192, pR, pC); const int Rb = P::PERM ? ((pR & ~31) + perm32(pR & 31)) : pR; voffB[i] = (unsigned)(Rb * KB + pC * 2); voffA[i] = (unsigned)(pR * KB + pC * 2); c2 = (unsigned)(pC * 2); }
    const size_t kstep = (size_t)(BK * 2);
    const size_t hstep = (size_t)HALF * KB;
    const unsigned ldsw = (unsigned)wid * 1024u;
    const int aoff = lds_byte(wr * 64 + fr, fq * 8), boff = lds_byte(wc * 32 + fr, fq * 8);
#define PG8_SA(b, h) (((b) * 2 + (h)) * HTB)
#define PG8_SB(b, h) ((4 + (b) * 2 + (h)) * HTB)
#define PG8_STAGE(bufoff, gbase, voff) do { _Pragma("unroll") for (int _i = 0; _i < 2; ++_i) \
        __builtin_amdgcn_global_load_lds((const unsigned*)((const char*)(gbase) + (voff)[_i]), (LAS unsigned*)(lds + (bufoff) + ldsw + _i * 8192), 16, 0, 0); } while (0)
#define PG8_STAGE_A(bufoff, gbase, h, PK) do { _Pragma("unroll") for (int _i = 0; _i < 2; ++_i) { \
        if constexpr (GATHER) { const unsigned _o = (((PK)[h] >> (16 * _i)) & 0xffffu) * (unsigned)KB + c2; \
            __builtin_amdgcn_global_load_lds((const unsigned*)((const char*)(gbase) + _o), (LAS unsigned*)(lds + (bufoff) + ldsw + _i * 8192), 16, 0, 0); } \
        else __builtin_amdgcn_global_load_lds((const unsigned*)((const char*)(gbase) + (h) * hstep + voffA[_i]), (LAS unsigned*)(lds + (bufoff) + ldsw + _i * 8192), 16, 0, 0); } } while (0)
#define PG8_LDA(dst, b, h) do { _Pragma("unroll") for (int m = 0; m < 4; ++m) { \
        if constexpr (FP8) { const i32x4 lo_ = *(const LAS i32x4*)(lds + PG8_SA(b, h) + aoff + m * 2048), hi_ = *(const LAS i32x4*)(lds + PG8_SA(b, h) + aoff + m * 2048 + 1024); dst##8[m] = __builtin_shufflevector(lo_, hi_, 0, 1, 2, 3, 4, 5, 6, 7); } \
        else { _Pragma("unroll") for (int k = 0; k < 2; ++k) dst[m][k] = *(const LAS bf16x8*)(lds + PG8_SA(b, h) + aoff + m * 2048 + k * 1024); } } } while (0)
#define PG8_LDB(dst, b, h) do { _Pragma("unroll") for (int n = 0; n < 2; ++n) { \
        if constexpr (FP8) { const i32x4 lo_ = *(const LAS i32x4*)(lds + PG8_SB(b, h) + boff + n * 2048), hi_ = *(const LAS i32x4*)(lds + PG8_SB(b, h) + boff + n * 2048 + 1024); dst##8[n] = __builtin_shufflevector(lo_, hi_, 0, 1, 2, 3, 4, 5, 6, 7); } \
        else { _Pragma("unroll") for (int k = 0; k < 2; ++k) dst[n][k] = *(const LAS bf16x8*)(lds + PG8_SB(b, h) + boff + n * 2048 + k * 1024); } } } while (0)
#define PG8_MMA(ai, bj, At, Bt) do { __builtin_amdgcn_s_setprio(1); _Pragma("unroll") for (int m = 0; m < 4; ++m) _Pragma("unroll") for (int n = 0; n < 2; ++n) { \
        if constexpr (FP8) mfma_fp8_inplace(acc[ai][bj][m][n], Bt##8[n], At##8[m], sc_w, sc_x); \
        else { _Pragma("unroll") for (int k = 0; k < 2; ++k) acc[ai][bj][m][n] = __builtin_amdgcn_mfma_f32_16x16x32_bf16(Bt[n][k], At[m][k], acc[ai][bj][m][n], 0, 0, 0); } } \
        __builtin_amdgcn_s_setprio(0); } while (0)
#define PG8_WAIT_V(n) asm volatile("s_waitcnt vmcnt(" #n ")" ::: "memory")
#define PG8_WAIT_L(n) asm volatile("s_waitcnt lgkmcnt(" #n ")" ::: "memory")
#define PG8_BAR __builtin_amdgcn_s_barrier()
#define PG8_SCHED __builtin_amdgcn_sched_barrier(0)
    Unit cur, nxt; int ui = 0;
    if (!S.next(0, cur)) return;
    unsigned cpk[2] = {0u, 0u}, npk[2] = {0u, 0u};
    if constexpr (GATHER) S.a_rows(cur, cpk);
    bool has_next = S.next(1, nxt);
    if constexpr (GATHER) { npk[0] = cpk[0]; npk[1] = cpk[1]; if (has_next) S.ids_prefetch(nxt, lds + LDS_IDS + 1024, wid, lane); }
    f32x4 acc[2][2][4][2];
#pragma unroll
    for (int a = 0; a < 2; ++a)
#pragma unroll
        for (int b = 0; b < 2; ++b)
#pragma unroll
            for (int m = 0; m < 4; ++m)
#pragma unroll
                for (int n = 0; n < 2; ++n) acc[a][b][m][n] = (f32x4){0.f, 0.f, 0.f, 0.f};
    bf16x8 At[4][2], B0[2][2], B1[2][2]; i32x8 At8[4], B08[2], B18[2];
    int sc_w = W8_E8M0, sc_x = A8_E8M0; asm volatile("" : "+v"(sc_w), "+v"(sc_x));
    const char* cA = S.a_base(cur); const char* cB = S.b_base(cur);
    S.prefetch(cur, lds + LDS_PF, wid, lane);
    PG8_STAGE(PG8_SB(0, 0), cB, voffB); PG8_STAGE_A(PG8_SA(0, 0), cA, 0, cpk); PG8_STAGE(PG8_SB(0, 1), cB + hstep, voffB); PG8_STAGE_A(PG8_SA(0, 1), cA, 1, cpk);
    if (wr == 1) PG8_BAR;
    PG8_WAIT_V(4); PG8_BAR;
    PG8_STAGE(PG8_SB(1, 0), cB + kstep, voffB); PG8_STAGE_A(PG8_SA(1, 0), cA + kstep, 0, cpk); PG8_STAGE(PG8_SB(1, 1), cB + hstep + kstep, voffB);
    PG8_WAIT_V(6); PG8_BAR;
    for (;;) {
        const char* nA = has_next ? S.a_base(nxt) : cA; const char* nB = has_next ? S.b_base(nxt) : cB;
#pragma unroll 1
        for (int t = 0; t < nt; t += 2) {
            const bool last = (t == nt - 2);
            const char* a1 = cA + (size_t)(t + 1) * kstep;
            const char* a2 = last ? nA : cA + (size_t)(t + 2) * kstep; const char* b2 = last ? nB : cB + (size_t)(t + 2) * kstep;
            const char* a3 = a2 + kstep; const char* b3 = b2 + kstep;
            if constexpr (GATHER) { if (last && has_next) S.ids_read(nxt, lds + LDS_IDS + ((ui + 1) & 1) * 1024, npk); }
            PG8_LDB(B0, 0, 0); PG8_SCHED; PG8_LDA(At, 0, 0); PG8_STAGE_A(PG8_SA(1, 1), a1, 1, cpk);
            if constexpr (GATHER) { if (last) { cpk[0] = npk[0]; cpk[1] = npk[1]; } }
            PG8_WAIT_L(8); PG8_BAR; PG8_WAIT_L(0); PG8_MMA(0, 0, At, B0); PG8_BAR; PG8_SCHED;
            PG8_LDB(B1, 0, 1); PG8_STAGE(PG8_SB(0, 0), b2, voffB);
            PG8_BAR; PG8_WAIT_L(0); PG8_MMA(0, 1, At, B1); PG8_BAR;
            PG8_LDA(At, 0, 1); PG8_STAGE_A(PG8_SA(0, 0), a2, 0, cpk);
            PG8_BAR; PG8_WAIT_L(0); PG8_MMA(1, 0, At, B0); PG8_BAR; PG8_SCHED;
            PG8_STAGE(PG8_SB(0, 1), b2 + hstep, voffB);
            PG8_WAIT_V(6); PG8_BAR; PG8_MMA(1, 1, At, B1); PG8_BAR;
            PG8_LDB(B0, 1, 0); PG8_SCHED; PG8_LDA(At, 1, 0); PG8_STAGE_A(PG8_SA(0, 1), a2, 1, cpk);
            PG8_WAIT_L(8); PG8_BAR; PG8_WAIT_L(0); PG8_MMA(0, 0, At, B0); PG8_BAR; PG8_SCHED;
            PG8_LDB(B1, 1, 1); PG8_STAGE(PG8_SB(1, 0), b3, voffB);
            PG8_BAR; PG8_WAIT_L(0); PG8_MMA(0, 1, At, B1); PG8_BAR;
            PG8_LDA(At, 1, 1); PG8_STAGE_A(PG8_SA(1, 0), a3, 0, cpk);
            PG8_BAR; PG8_WAIT_L(0); PG8_MMA(1, 0, At, B0); PG8_BAR; PG8_SCHED;
            PG8_STAGE(PG8_SB(1, 1), b3 + hstep, voffB);
            PG8_WAIT_V(6); PG8_BAR; PG8_MMA(1, 1, At, B1); PG8_BAR;
        }
        if constexpr (FP8) {
#pragma unroll
            for (int a = 0; a < 2; ++a)
#pragma unroll
                for (int b = 0; b < 2; ++b)
                    asm volatile("s_nop 15\n\ts_nop 15" : "+v"(acc[a][b][0][0]), "+v"(acc[a][b][0][1]), "+v"(acc[a][b][1][0]), "+v"(acc[a][b][1][1]), "+v"(acc[a][b][2][0]), "+v"(acc[a][b][2][1]), "+v"(acc[a][b][3][0]), "+v"(acc[a][b][3][1]) :: "memory");
        }
        Unit nn = nxt; const bool has_nn = has_next ? S.next(ui + 2, nn) : false;
        S.epi(acc, cur, wr, wc, fr, fq, lds + LDS_PF + (ui & 1) * PF_BYTES);
        if (!has_next) break;
#pragma unroll
        for (int a = 0; a < 2; ++a)
#pragma unroll
            for (int b = 0; b < 2; ++b)
#pragma unroll
                for (int m = 0; m < 4; ++m)
#pragma unroll
                    for (int n = 0; n < 2; ++n) acc[a][b][m][n] = (f32x4){0.f, 0.f, 0.f, 0.f};
        cur = nxt; cA = nA; cB = nB; ++ui;
        S.prefetch(cur, lds + LDS_PF + (ui & 1) * PF_BYTES, wid, lane);
        nxt = nn; has_next = has_nn;
        if constexpr (GATHER) { if (has_next) S.ids_prefetch(nxt, lds + LDS_IDS + ((ui + 1) & 1) * 1024, wid, lane); }
    }
    PG8_WAIT_V(0);
    if (wr == 0) PG8_BAR;
    PG8_BAR;
#undef PG8_SA
#undef PG8_SB
#undef PG8_STAGE
#undef PG8_STAGE_A
#undef PG8_LDA
#undef PG8_LDB
#undef PG8_MMA
#undef PG8_WAIT_V
#undef PG8_WAIT_L
#undef PG8_BAR
#undef PG8_SCHED
}

__device__ __forceinline__ bool static_next(int i, int G, int c, int nM, int nN, Unit& u) {
    const int nwg = nM * nN; const long L = (long)i * G + c; if (L >= nwg) return false;
    int wgid = (int)L; { const int q = nwg / 8, r = nwg % 8, xcd = wgid % 8, off = wgid / 8; wgid = (xcd < r ? xcd * (q + 1) : r * (q + 1) + (xcd - r) * q) + off; }
    const int nig = 8 * nN, gid = wgid / nig, fm = gid * 8, gsz = (nM - fm) < 8 ? (nM - fm) : 8;
    u.pm = fm + ((wgid % nig) % gsz); u.pn = (wgid % nig) / gsz; u.e = 0; u.rows = 256; u.rt = u.pm; return true;
}

struct ProbIn {
    static constexpr bool PERM = true, GATHER = false;
    const bf16_t* A; const bf16_t* Bt; bf16_t* O; int G, c;
    __device__ __forceinline__ bool next(int i, Unit& u) const { return static_next(i, G, c, NTOK / BM, DIN / BM, u); }
    __device__ __forceinline__ void prefetch(const Unit&, LAS unsigned char*, int, int) const {}
    __device__ __forceinline__ const char* a_base(const Unit& u) const { return (const char*)A + (size_t)u.pm * BM * GK * 2; }
    __device__ __forceinline__ const char* b_base(const Unit& u) const { return (const char*)Bt + (size_t)u.pn * BM * GK * 2; }
    __device__ __forceinline__ void epi(const f32x4 (&acc)[2][2][4][2], const Unit& u, int wr, int wc, int fr, int fq, const LAS unsigned char* pf) const {
        int row0 = u.pm * BM + wr * 64 + fr, col0 = u.pn * BM + wc * 32 + 8 * fq;
        asm volatile("" : "+v"(row0), "+v"(col0));
        auto Ob = launder(O);
#pragma unroll
        for (int ai = 0; ai < 2; ++ai)
#pragma unroll
            for (int m = 0; m < 4; ++m) { auto rowp = Ob + (size_t)(row0 + ai * HALF + m * 16) * DIN + col0;
#pragma unroll
                for (int bj = 0; bj < 2; ++bj) { const f32x4 v0 = acc[ai][bj][m][0], v1 = acc[ai][bj][m][1];
                    u32x4 w; w.x = cvt_pk_bf16(v0[0], v0[1]); w.y = cvt_pk_bf16(v0[2], v0[3]); w.z = cvt_pk_bf16(v1[0], v1[1]); w.w = cvt_pk_bf16(v1[2], v1[3]);
                    *(u32x4*)(rowp + bj * HALF) = w; } }
    }
};
struct ProbOut {
    static constexpr bool PERM = true, GATHER = false;
    const bf16_t* A; const bf16_t* Bt; const float* X; bf16_t* O; int G, c;
    __device__ __forceinline__ bool next(int i, Unit& u) const { return static_next(i, G, c, NTOK / BM, D / BM, u); }
    __device__ __forceinline__ void prefetch(const Unit&, LAS unsigned char*, int, int) const {}
    __device__ __forceinline__ const char* a_base(const Unit& u) const { return (const char*)A + (size_t)u.pm * BM * GK * 2; }
    __device__ __forceinline__ const char* b_base(const Unit& u) const { return (const char*)Bt + (size_t)u.pn * BM * GK * 2; }
    __device__ __forceinline__ void epi(const f32x4 (&acc)[2][2][4][2], const Unit& u, int wr, int wc, int fr, int fq, const LAS unsigned char* pf) const {
        int row0 = u.pm * BM + wr * 64 + fr, col0 = u.pn * BM + wc * 32 + 8 * fq;
        asm volatile("" : "+v"(row0), "+v"(col0));
        auto Xb = launder(X); auto Ob = launder(O);
#pragma unroll
        for (int ai = 0; ai < 2; ++ai) {
            f32x4 xv[4][2][2];
#pragma unroll
            for (int m = 0; m < 4; ++m) { const size_t ro = (size_t)(row0 + ai * HALF + m * 16) * D + col0;
#pragma unroll
                for (int bj = 0; bj < 2; ++bj)
#pragma unroll
                    for (int n = 0; n < 2; ++n) xv[m][bj][n] = *(const f32x4*)(Xb + ro + bj * HALF + n * 4); }
            __builtin_amdgcn_sched_barrier(0);
#pragma unroll
            for (int m = 0; m < 4; ++m) { const size_t ro = (size_t)(row0 + ai * HALF + m * 16) * D + col0;
#pragma unroll
                for (int bj = 0; bj < 2; ++bj) { const f32x4 v0 = acc[ai][bj][m][0] + xv[m][bj][0], v1 = acc[ai][bj][m][1] + xv[m][bj][1];
                    u32x4 w; w.x = cvt_pk_bf16(v0[0], v0[1]); w.y = cvt_pk_bf16(v0[2], v0[3]); w.z = cvt_pk_bf16(v1[0], v1[1]); w.w = cvt_pk_bf16(v1[2], v1[3]);
                    *(u32x4*)(Ob + ro + bj * HALF) = w; } }
        }
    }
};
struct MoeSched { const LAS int* cnt; const LAS int* tbase; int G, vcu; };
__device__ __forceinline__ bool moe_next(const MoeSched& M, int i, int ncol, Unit& u) {
    const int L = i * M.G + M.vcu, total = M.tbase[NE] * ncol; if (L >= total) return false;
    const int ln = (int)threadIdx.x & 63, tb = M.tbase[ln < NE ? ln + 1 : NE];
    const int e = (int)__popcll(__ballot(ln < NE - 1 && L >= tb * ncol));
    const int tiles = M.tbase[e + 1] - M.tbase[e], loc = L - M.tbase[e] * ncol;
    u.e = e; u.pn = loc / tiles; u.pm = loc % tiles; u.rt = M.tbase[e] + u.pm;
    const int rem = M.cnt[e] - u.pm * BM; u.rows = rem < BM ? rem : BM; return true;
}
struct ProbGU {
    static constexpr bool PERM = true, GATHER = true;
    const fp8_t* U1; const fp8_t* WguT; const float* bgu; const int* list; fp8_t* ACT; MoeSched M;
    __device__ __forceinline__ bool next(int i, Unit& u) const { return moe_next(M, i, 8, u); }
    __device__ __forceinline__ void ids_prefetch(const Unit& u, LAS unsigned char* ids, int wave, int lane) const {
        if (wave < 4) __builtin_amdgcn_global_load_lds((const unsigned*)(list + (size_t)u.e * NTOK + u.pm * BM + 64 * wave + lane), (LAS unsigned*)(ids + wave * 256), 4, 0, 0); }
    __device__ __forceinline__ void ids_read(const Unit& u, const LAS unsigned char* ids, unsigned (&pk)[2]) const {
        int pR, pC; stage_rc((int)threadIdx.x * 16, pR, pC);
#pragma unroll
        for (int h = 0; h < 2; ++h) { const int r0 = h * HALF + pR, r1 = r0 + 64;
            const int p0 = *(const LAS int*)(ids + 4 * ((r0 < u.rows) ? r0 : 0)), p1 = *(const LAS int*)(ids + 4 * ((r1 < u.rows) ? r1 : 0));
            pk[h] = (unsigned)(p0 >> 2) | ((unsigned)(p1 >> 2) << 16); }
    }
    __device__ __forceinline__ void prefetch(const Unit& u, LAS unsigned char* pf, int wave, int lane) const {
        if (wave < 4) __builtin_amdgcn_global_load_lds((const unsigned*)(bgu + (size_t)u.e * DIN + u.pn * BM + 64 * wave + lane), (LAS unsigned*)(pf + wave * 256), 4, 0, 0); }
    __device__ __forceinline__ const char* a_base(const Unit&) const { return (const char*)U1; }
    __device__ __forceinline__ const char* b_base(const Unit& u) const { return (const char*)WguT + ((size_t)u.e * DIN + (size_t)u.pn * BM) * GK; }
    __device__ __forceinline__ void a_rows(const Unit& u, unsigned (&pk)[2]) const {
        const int* le = list + (size_t)u.e * NTOK + u.pm * BM;
        int pR, pC; stage_rc((int)threadIdx.x * 16, pR, pC);
#pragma unroll
        for (int h = 0; h < 2; ++h) { const int r0 = h * HALF + pR, r1 = r0 + 64;
            const int p0 = (r0 < u.rows) ? le[r0] : le[0], p1 = (r1 < u.rows) ? le[r1] : le[0];
            pk[h] = (unsigned)(p0 >> 2) | ((unsigned)(p1 >> 2) << 16); }
    }
    __device__ __forceinline__ void epi(const f32x4 (&acc)[2][2][4][2], const Unit& u, int wr, int wc, int fr, int fq, const LAS unsigned char* pf) const {
        int j0 = u.pn * HALF + wc * 32 + 8 * fq;
        int row0 = wr * 64 + fr;
        asm volatile("" : "+v"(row0), "+v"(j0));
        auto ACTb = launder(ACT);
        const LAS f32x4* bp = (const LAS f32x4*)(pf + (wc * 64 + 16 * fq) * 4);
        const f32x4 b0 = bp[0], b1 = bp[1], b2 = bp[2], b3 = bp[3];
        const float bg[8] = {b0[0], b0[2], b1[0], b1[2], b2[0], b2[2], b3[0], b3[2]};
        const float bl[8] = {b0[1], b0[3], b1[1], b1[3], b2[1], b2[3], b3[1], b3[3]};
#pragma unroll
        for (int ai = 0; ai < 2; ++ai)
#pragma unroll
            for (int m = 0; m < 4; ++m) {
                const int r = row0 + ai * HALF + m * 16;
                float o[8];
#pragma unroll
                for (int n = 0; n < 2; ++n)
#pragma unroll
                    for (int x = 0; x < 4; x += 2) {
                        f32x2 g = (f32x2){acc[ai][0][m][n][x], acc[ai][0][m][n][x + 1]} + (f32x2){bg[4 * n + x], bg[4 * n + x + 1]};
                        f32x2 l = (f32x2){acc[ai][1][m][n][x], acc[ai][1][m][n][x + 1]} + (f32x2){bl[4 * n + x], bl[4 * n + x + 1]};
                        g[0] = fminf(g[0], 7.0f); g[1] = fminf(g[1], 7.0f);
                        l[0] = __builtin_amdgcn_fmed3f(l[0], -7.0f, 7.0f); l[1] = __builtin_amdgcn_fmed3f(l[1], -7.0f, 7.0f);
                        const f32x2 t = g * (-1.702f * 1.4426950408889634f);
                        f32x2 d; d[0] = __builtin_amdgcn_exp2f(t[0]); d[1] = __builtin_amdgcn_exp2f(t[1]);
                        d = d + 1.0f;
                        f32x2 r; r[0] = __builtin_amdgcn_rcpf(d[0]); r[1] = __builtin_amdgcn_rcpf(d[1]);
                        const f32x2 res = (g * r) * (l * A8_SCALE + A8_SCALE);
                        o[4 * n + x] = res[0]; o[4 * n + x + 1] = res[1];
                    }
                u32x2 w; w.x = pk4_fp8(o[0], o[1], o[2], o[3]); w.y = pk4_fp8(o[4], o[5], o[6], o[7]);
                *(u32x2*)(ACTb + ((size_t)u.rt * BM + r) * D + j0) = w;
            }
    }
};
struct ProbDown {
    static constexpr bool PERM = true, GATHER = false;
    const fp8_t* ACT; const fp8_t* WdT; const float* bd; const int* list; const float* gatew; fp8_t* Y; MoeSched M;
    __device__ __forceinline__ bool next(int i, Unit& u) const { return moe_next(M, i, 4, u); }
    __device__ __forceinline__ void prefetch(const Unit& u, LAS unsigned char* pf, int wave, int lane) const {
        const size_t o = (size_t)u.e * NTOK + u.pm * BM + 64 * (wave & 3) + lane;
        const unsigned* src = (wave < 4) ? (const unsigned*)(list + o) : (const unsigned*)(gatew + o);
        __builtin_amdgcn_global_load_lds(src, (LAS unsigned*)(pf + wave * 256), 4, 0, 0);
        if (wave < 4) __builtin_amdgcn_global_load_lds((const unsigned*)(bd + (size_t)u.e * D + u.pn * BM + 64 * wave + lane), (LAS unsigned*)(pf + 2048 + wave * 256), 4, 0, 0); }
    __device__ __forceinline__ const char* a_base(const Unit& u) const { return (const char*)ACT + (size_t)u.rt * BM * GK; }
    __device__ __forceinline__ const char* b_base(const Unit& u) const { return (const char*)WdT + ((size_t)u.e * D + (size_t)u.pn * BM) * GK; }
    __device__ __forceinline__ void epi(const f32x4 (&acc)[2][2][4][2], const Unit& u, int wr, int wc, int fr, int fq, const LAS unsigned char* pf) const {
        int col0 = u.pn * BM + wc * 32 + 8 * fq, row0 = wr * 64 + fr;
        asm volatile("" : "+v"(row0), "+v"(col0));
        auto Yb = launder(Y);
        f32x4 bv[2][2];
#pragma unroll
        for (int bj = 0; bj < 2; ++bj)
#pragma unroll
            for (int n = 0; n < 2; ++n) bv[bj][n] = *(const LAS f32x4*)(pf + 2048 + (wc * 32 + 8 * fq + bj * HALF + 4 * n) * 4);
        int pr[8]; float gw[8];
#pragma unroll
        for (int k = 0; k < 8; ++k) { const int r = row0 + (k >> 2) * HALF + (k & 3) * 16; pr[k] = *(const LAS int*)(pf + 4 * r); gw[k] = *(const LAS float*)(pf + 1024 + 4 * r); }
#pragma unroll
        for (int ai = 0; ai < 2; ++ai)
#pragma unroll
            for (int m = 0; m < 4; ++m) {
                const int r = row0 + ai * HALF + m * 16, k = ai * 4 + m;
                u32x2 w[2];
#pragma unroll
                for (int bj = 0; bj < 2; ++bj) { const f32x4 v0 = (acc[ai][bj][m][0] + bv[bj][0]) * (gw[k] * Y8_SCALE), v1 = (acc[ai][bj][m][1] + bv[bj][1]) * (gw[k] * Y8_SCALE);
                    w[bj].x = pk4_fp8(v0[0], v0[1], v0[2], v0[3]); w[bj].y = pk4_fp8(v1[0], v1[1], v1[2], v1[3]); }
                if (r < u.rows) { auto rowp = Yb + (size_t)pr[k] * D + col0; *(u32x2*)(rowp) = w[0]; *(u32x2*)(rowp + HALF) = w[1]; }
            }
    }
};

__device__ __forceinline__ float wave_dot_bf16(const bf16_t* a, const bf16_t* b, int lane) {
    const u32x4 a0 = *(const u32x4*)(a + 16 * lane), a1 = *(const u32x4*)(a + 16 * lane + 8);
    const u32x4 b0 = *(const u32x4*)(b + 16 * lane), b1 = *(const u32x4*)(b + 16 * lane + 8);
    float s = 0.f;
#pragma unroll
    for (int j = 0; j < 4; ++j) { s += bflo(a0[j]) * bflo(b0[j]) + bfhi(a0[j]) * bfhi(b0[j]); s += bflo(a1[j]) * bflo(b1[j]) + bfhi(a1[j]) * bfhi(b1[j]); }
    return wave_sum(s);
}

struct Frame {
    LAS unsigned char* lds;
    int tid, lane, wave, G, vcu, gw, NGW;
    const float* in[24]; float* out; unsigned char* ws;
    unsigned* ctl;
    bf16_t *WinT, *WoutT, *WaT, *WxT, *UMETA, *ZMETA, *U0, *Z, *MIX;
    fp8_t *WguT, *WdT, *U1, *ACT, *Y;
    float *WR, *HMETA, *SUMM, *GATEW; bf16_t* H1;
    int* LIST;
};

template <int MAP, bool FP8, bool NT = false>
__device__ __forceinline__ void p0_transpose_item(const float* W, int K, int N, void* WTv, LAS float* scr, int item, int lane) {
    const int nblk = N / 64, kb = item / nblk, nb = item % nblk, k0 = 64 * kb, n0 = 64 * nb;
    if (NT) {
        f32x4 v[16];
#pragma unroll
        for (int i = 0; i < 16; ++i) { const int kk = 4 * i + (lane >> 4); v[i] = __builtin_nontemporal_load((const f32x4*)(W + (size_t)(k0 + kk) * N + n0 + 4 * (lane & 15))); }
        __builtin_amdgcn_sched_barrier(0);
#pragma unroll
        for (int i = 0; i < 16; ++i) { const int kk = 4 * i + (lane >> 4); LAS float* s = scr + kk * 65 + 4 * (lane & 15); s[0] = v[i][0]; s[1] = v[i][1]; s[2] = v[i][2]; s[3] = v[i][3]; }
    } else {
#pragma unroll 4
    for (int i = 0; i < 16; ++i) { const int kk = 4 * i + (lane >> 4); const f32x4* wp = (const f32x4*)(W + (size_t)(k0 + kk) * N + n0 + 4 * (lane & 15)); const f32x4 v = *wp;
        LAS float* s = scr + kk * 65 + 4 * (lane & 15); s[0] = v[0]; s[1] = v[1]; s[2] = v[2]; s[3] = v[3]; }
    }
    asm volatile("s_waitcnt lgkmcnt(0)" ::: "memory");
    const int c = lane & 7;
#pragma unroll
    for (int j = 0; j < 8; ++j) { const int n = (lane >> 3) + 8 * j; const LAS float* s = scr + (8 * c) * 65 + n;
        const int ng = n0 + n; int row = ng;
        if (MAP == 1) { const int jj = ng >> 1, half = ng & 1; row = (jj >> 7) * 256 + half * 128 + (jj & 127); }
        if (FP8) { u32x2 o; o.x = pk4_fp8(s[0 * 65] * W8_SCALE, s[1 * 65] * W8_SCALE, s[2 * 65] * W8_SCALE, s[3 * 65] * W8_SCALE); o.y = pk4_fp8(s[4 * 65] * W8_SCALE, s[5 * 65] * W8_SCALE, s[6 * 65] * W8_SCALE, s[7 * 65] * W8_SCALE);
            *(u32x2*)((fp8_t*)WTv + (size_t)row * K + k0 + 8 * c) = o; }
        else { u32x4 o; o.x = pk2(s[0 * 65], s[1 * 65]); o.y = pk2(s[2 * 65], s[3 * 65]); o.z = pk2(s[4 * 65], s[5 * 65]); o.w = pk2(s[6 * 65], s[7 * 65]);
            *(u32x4*)((bf16_t*)WTv + (size_t)row * K + k0 + 8 * c) = o; } }
    asm volatile("s_waitcnt lgkmcnt(0)" ::: "memory");
}
__device__ __forceinline__ void rms_row_to_bf16(const float* xrow, const float* g, bf16_t* orow, int lane) {
    f32x4 v[4]; float s = 0.f;
#pragma unroll
    for (int j = 0; j < 4; ++j) { v[j] = *(const f32x4*)(xrow + 4 * lane + 256 * j); s += (v[j][0] * v[j][0] + v[j][1] * v[j][1]) + (v[j][2] * v[j][2] + v[j][3] * v[j][3]); }
    const float rstd = 1.0f / sqrtf(wave_sum(s) * (1.0f / D) + NORM_EPS);
#pragma unroll
    for (int j = 0; j < 4; ++j) { const f32x4 gv = *(const f32x4*)(g + 4 * lane + 256 * j);
        u32x2 o; o.x = pk2(v[j][0] * rstd * gv[0], v[j][1] * rstd * gv[1]); o.y = pk2(v[j][2] * rstd * gv[2], v[j][3] * rstd * gv[3]);
        *(u32x2*)(orow + 4 * lane + 256 * j) = o; }
}
__device__ __forceinline__ void expert_weights_to_fp8(Frame& F, int vw, int nvw, int k_lo, int k_hi) {
    LAS float* scr = (LAS float*)(F.lds + 4096 + F.wave * 16640);
    constexpr int I_GU = NE * (D / 64) * (DIN / 64), I_D = NE * (D / 64) * (D / 64);
    for (int k = k_lo; k < k_hi; ++k) {
        int r = k * nvw + vw; if (r >= I_D + I_GU) break;
        if (r < I_D) { const int e = r / (I_D / NE), q = r % (I_D / NE); p0_transpose_item<0, true, true>(F.in[I_WD] + (size_t)e * D * D, D, D, F.WdT + (size_t)e * D * D, scr, q, F.lane); continue; } r -= I_D;
        { const int e = r / (I_GU / NE), q = r % (I_GU / NE); p0_transpose_item<1, true, true>(F.in[I_WGU] + (size_t)e * D * DIN, D, DIN, F.WguT + (size_t)e * DIN * D, scr, q, F.lane); }
    }
}
__device__ __forceinline__ void p0_prologue(Frame& F) {
    LAS float* scr = (LAS float*)(F.lds + F.wave * 16640);
    constexpr int I_IN = (D / 64) * (DIN / 64), I_OUT = (D / 64) * (D / 64), I_G = 2 * NH;
    constexpr int NITEMS = I_IN + I_OUT + I_G;
    for (int it = F.gw; it < NITEMS; it += F.NGW) {
        int r = it;
        if (r < I_IN) { p0_transpose_item<0, false>(F.in[I_WIN], D, DIN, F.WinT, scr, r, F.lane); continue; } r -= I_IN;
        if (r < I_OUT) { p0_transpose_item<0, false>(F.in[I_WOUT], D, D, F.WoutT, scr, r, F.lane); continue; } r -= I_OUT;
        { const int h = r >> 1; if (r & 1) p0_transpose_item<0, false>(F.in[I_WX] + h * HD * HD, HD, HD, F.WxT + h * HD * HD, scr, 0, F.lane);
          else p0_transpose_item<0, false>(F.in[I_WA] + h * HD * HD, HD, HD, F.WaT + h * HD * HD, scr, 0, F.lane); }
    }
    {
        f32x4 gv[4];
#pragma unroll
        for (int j = 0; j < 4; ++j) gv[j] = *(const f32x4*)(F.in[I_GMIX] + 4 * F.lane + 256 * j);
#pragma unroll 1
        for (int m0 = F.gw; m0 < NTOK + NMETA; m0 += 4 * F.NGW) {
            f32x4 v[4][4]; float ss[4];
#pragma unroll
            for (int i = 0; i < 4; ++i) { int m = m0 + i * F.NGW; m = m < NTOK + NMETA ? m : m0;
                const float* xr = (m < NTOK) ? F.in[I_X] + (size_t)m * D : F.in[I_META] + (size_t)(m - NTOK) * D;
#pragma unroll
                for (int j = 0; j < 4; ++j) v[i][j] = *(const f32x4*)(xr + 4 * F.lane + 256 * j); }
            __builtin_amdgcn_sched_barrier(0);
#pragma unroll
            for (int i = 0; i < 4; ++i) { float sq = 0.f;
#pragma unroll
                for (int j = 0; j < 4; ++j) sq += (v[i][j][0] * v[i][j][0] + v[i][j][1] * v[i][j][1]) + (v[i][j][2] * v[i][j][2] + v[i][j][3] * v[i][j][3]);
                ss[i] = sq; }
#pragma unroll
            for (int o = 1; o < 64; o <<= 1) {
#pragma unroll
                for (int i = 0; i < 4; ++i) ss[i] += __shfl_xor(ss[i], o); }
#pragma unroll
            for (int i = 0; i < 4; ++i) { const int m = m0 + i * F.NGW;
                if (m < NTOK + NMETA) { const float rstd = 1.0f / sqrtf(ss[i] * (1.0f / D) + NORM_EPS);
                    bf16_t* orow = (m < NTOK) ? F.U0 + (size_t)m * D : F.UMETA + (size_t)(m - NTOK) * D;
#pragma unroll
                    for (int j = 0; j < 4; ++j) { u32x2 o; o.x = pk2(v[i][j][0] * rstd * gv[j][0], v[i][j][1] * rstd * gv[j][1]); o.y = pk2(v[i][j][2] * rstd * gv[j][2], v[i][j][3] * rstd * gv[j][3]);
                        *(u32x2*)(orow + 4 * F.lane + 256 * j) = o; } } }
        }
    }
    for (int i = blockIdx.x * NTHREADS + F.tid; i < D * NE; i += F.G * NTHREADS) { const int k = i >> 5, e = i & 31; const float w = F.in[I_GFFN][k] * F.in[I_WROUTER][i];
        const unsigned hi = f2bf(w), lo = f2bf(w - bf2f(hi)); bf16_t* wr = (bf16_t*)F.WR; wr[e * D + k] = (bf16_t)hi; wr[NE * D + e * D + k] = (bf16_t)lo; }
}

__device__ __forceinline__ void p1_zmeta(Frame& F) {
    for (int n = F.gw; n < DIN; n += F.NGW) {
        const bf16_t* wrow = F.WinT + (size_t)n * D + 16 * F.lane;
        const u32x4 b0 = *(const u32x4*)(wrow), b1 = *(const u32x4*)(wrow + 8);
#pragma unroll 1
        for (int r0 = 0; r0 < NMETA; r0 += 8) {
            u32x4 a0[8], a1[8]; float s[8];
#pragma unroll
            for (int i = 0; i < 8; ++i) { const bf16_t* ar = F.UMETA + (size_t)(r0 + i) * D + 16 * F.lane; a0[i] = *(const u32x4*)(ar); a1[i] = *(const u32x4*)(ar + 8); }
            __builtin_amdgcn_sched_barrier(0);
#pragma unroll
            for (int i = 0; i < 8; ++i) { float t = 0.f;
#pragma unroll
                for (int j = 0; j < 4; ++j) { t += bflo(a0[i][j]) * bflo(b0[j]) + bfhi(a0[i][j]) * bfhi(b0[j]); t += bflo(a1[i][j]) * bflo(b1[j]) + bfhi(a1[i][j]) * bfhi(b1[j]); }
                s[i] = t; }
#pragma unroll
            for (int o = 1; o < 64; o <<= 1) {
#pragma unroll
                for (int i = 0; i < 8; ++i) s[i] += __shfl_xor(s[i], o); }
            if (F.lane == 0) {
#pragma unroll
                for (int i = 0; i < 8; ++i) F.ZMETA[(size_t)(r0 + i) * DIN + n] = (bf16_t)f2bf(s[i]); }
        }
    }
}

__device__ __forceinline__ unsigned zrow_off(int b, int tp, float& valid) {
    const int tm = tp + NMETA; valid = (tm >= 0) ? 1.0f : 0.0f;
    const unsigned om = (unsigned)WS_ZMETA + (unsigned)(tm > 0 ? (tm < NMETA ? tm : NMETA - 1) : 0) * (unsigned)(DIN * 2);
    const unsigned oz = (unsigned)WS_Z + (unsigned)(b * SEQ + (tp > 0 ? tp : 0)) * (unsigned)(DIN * 2);
    return (tp >= 0) ? oz : om;
}
__device__ __forceinline__ void conformer_tile(Frame& F, int b, int t0) {
    LAS bf16_t* co = (LAS bf16_t*)F.lds;
    LAS float* wl = (LAS float*)(F.lds + 65536);
    const GAS unsigned char* wsg = (const GAS unsigned char*)F.ws;
    const int cp = F.tid & 255, half = F.tid >> 8, c0 = 2 * cp;
    auto cdw = launder(F.in[I_CDW]); auto cdb = launder(F.in[I_CDB]);
    auto lng = launder(F.in[I_CLNG]); auto lnb = launder(F.in[I_CLNB]);
    const f32x4 lg0 = *(const f32x4*)(lng + 8 * F.lane), lg1 = *(const f32x4*)(lng + 8 * F.lane + 4);
    const f32x4 lb0 = *(const f32x4*)(lnb + 8 * F.lane), lb1 = *(const f32x4*)(lnb + 8 * F.lane + 4);
    { f32x4 tw[8];
#pragma unroll
      for (int i = 0; i < 8; ++i) { const int idx = F.tid + i * NTHREADS; tw[i] = *(const f32x4*)(cdw + 4 * (idx < CK * CW / 4 ? idx : 0)); }
#pragma unroll
      for (int i = 0; i < 8; ++i) { const int idx = F.tid + i * NTHREADS; if (idx < CK * CW / 4) *(LAS f32x4*)(wl + 4 * idx) = tw[i]; } }
    const f32x2 cb = *(const f32x2*)(cdb + c0);
    float g0[38], g1[38];
    const int tb = t0 + 32 * half;
    auto row_ld = [&](int tp, unsigned& v, unsigned& g, float& ok) { const unsigned zo = zrow_off(b, tp, ok); v = *(const GAS unsigned*)(wsg + zo + 2 * c0); g = *(const GAS unsigned*)(wsg + zo + 2 * (CW + c0)); };
    auto glu = [&](unsigned v, unsigned g, float ok, float& o0, float& o1) { o0 = ok * bflo(v) * sigmoidf_(bflo(g)); o1 = ok * bfhi(v) * sigmoidf_(bfhi(g)); };
#pragma unroll
    for (int i0 = 0; i0 < 30; i0 += 15) {
        unsigned rv[15], rg[15]; float rk[15];
#pragma unroll
        for (int i = 0; i < 15; ++i) row_ld(tb - 30 + i0 + i, rv[i], rg[i], rk[i]);
        __builtin_amdgcn_sched_barrier(0);
#pragma unroll
        for (int i = 0; i < 15; ++i) glu(rv[i], rg[i], rk[i], g0[i0 + i], g1[i0 + i]);
    }
    unsigned nv[8], ng[8]; float nk[8];
#pragma unroll
    for (int i = 0; i < 8; ++i) row_ld(tb + i, nv[i], ng[i], nk[i]);
    __syncthreads();
#pragma unroll 1
    for (int run = 0; run < 4; ++run) {
        const int ts = tb + 8 * run;
#pragma unroll
        for (int i = 0; i < 8; ++i) glu(nv[i], ng[i], nk[i], g0[30 + i], g1[30 + i]);
        if (run < 3) {
#pragma unroll
            for (int i = 0; i < 8; ++i) row_ld(ts + 8 + i, nv[i], ng[i], nk[i]); }
        __builtin_amdgcn_sched_barrier(0);
        float a0[8], a1[8];
#pragma unroll
        for (int o = 0; o < 8; ++o) { a0[o] = cb[0]; a1[o] = cb[1]; }
#pragma unroll
        for (int k = 0; k < CK; ++k) { const f32x2 w = *(const LAS f32x2*)(wl + k * CW + c0);
#pragma unroll
            for (int o = 0; o < 8; ++o) { a0[o] += w[0] * g0[o + k]; a1[o] += w[1] * g1[o + k]; } }
#pragma unroll
        for (int o = 0; o < 8; ++o) *(LAS unsigned*)(co + (ts - t0 + o) * CW + c0) = pk2(a0[o], a1[o]);
#pragma unroll
        for (int i = 0; i < 30; ++i) { g0[i] = g0[i + 8]; g1[i] = g1[i + 8]; }
    }
    __syncthreads();
#pragma unroll 1
    for (int i0 = 0; i0 < 8; i0 += 4) {
        f32x4 v0[4], v1[4]; float mean[4], var[4];
#pragma unroll
        for (int i = 0; i < 4; ++i) { const int tl = F.wave * 8 + i0 + i; const u32x4 cv = *(const LAS u32x4*)(co + tl * CW + 8 * F.lane);
            v0[i] = (f32x4){bflo(cv[0]), bfhi(cv[0]), bflo(cv[1]), bfhi(cv[1])}; v1[i] = (f32x4){bflo(cv[2]), bfhi(cv[2]), bflo(cv[3]), bfhi(cv[3])};
            mean[i] = (v0[i][0] + v0[i][1]) + (v0[i][2] + v0[i][3]) + (v1[i][0] + v1[i][1]) + (v1[i][2] + v1[i][3]); }
#pragma unroll
        for (int o = 1; o < 64; o <<= 1) {
#pragma unroll
            for (int i = 0; i < 4; ++i) mean[i] += __shfl_xor(mean[i], o); }
#pragma unroll
        for (int i = 0; i < 4; ++i) { mean[i] *= (1.0f / CW); v0[i] = v0[i] - mean[i]; v1[i] = v1[i] - mean[i];
            var[i] = (v0[i][0] * v0[i][0] + v0[i][1] * v0[i][1]) + (v0[i][2] * v0[i][2] + v0[i][3] * v0[i][3]) + (v1[i][0] * v1[i][0] + v1[i][1] * v1[i][1]) + (v1[i][2] * v1[i][2] + v1[i][3] * v1[i][3]); }
#pragma unroll
        for (int o = 1; o < 64; o <<= 1) {
#pragma unroll
            for (int i = 0; i < 4; ++i) var[i] += __shfl_xor(var[i], o); }
#pragma unroll
        for (int i = 0; i < 4; ++i) { const int tl = F.wave * 8 + i0 + i; const float rstd = __builtin_amdgcn_rsqf(var[i] * (1.0f / CW) + LN_EPS);
            float y[8];
#pragma unroll
            for (int j = 0; j < 4; ++j) { y[j] = v0[i][j] * rstd * lg0[j] + lb0[j]; y[4 + j] = v1[i][j] * rstd * lg1[j] + lb1[j]; }
#pragma unroll
            for (int j = 0; j < 8; ++j) y[j] = y[j] * sigmoidf_(y[j]);
            u32x4 o; o.x = pk2(y[0], y[1]); o.y = pk2(y[2], y[3]); o.z = pk2(y[4], y[5]); o.w = pk2(y[6], y[7]);
            *(u32x4*)(F.MIX + ((size_t)b * SEQ + t0 + tl) * D + 8 * F.lane) = o; }
    }
    __syncthreads();
}
constexpr int XC_STRIDE = 520;
constexpr int LDS_XC = 0, LDS_AB = 64 * XC_STRIDE * 2, LDS_CARRY = LDS_AB + NWAVES * 8192;
template <bool FINAL>
__device__ __forceinline__ void lru_tile(Frame& F, int b, int t0, int first_valid, int start_tp, float* sa, float* sh) {
    LAS bf16_t* xc = (LAS bf16_t*)(F.lds + LDS_XC);
    const GAS unsigned char* wsg = (const GAS unsigned char*)F.ws;
    const int h = F.wave, lane = F.lane, q = lane >> 4, c16 = lane & 15;
    LAS f32x2* ab = (LAS f32x2*)(F.lds + LDS_AB + h * 8192);
    bf16x8 Ba[4][2], Bx[4][2];
    auto wat = launder(F.WaT); auto wxt = launder(F.WxT);
#pragma unroll
    for (int n = 0; n < 4; ++n)
#pragma unroll
        for (int ks = 0; ks < 2; ++ks) {
            Ba[n][ks] = *(const GAS bf16x8*)(wat + ((size_t)h * HD + n * 16 + c16) * HD + ks * 32 + 8 * q);
            Bx[n][ks] = *(const GAS bf16x8*)(wxt + ((size_t)h * HD + n * 16 + c16) * HD + ks * 32 + 8 * q);
        }
    float bav[4], bxv[4], lamv[4];
    auto pba = launder(F.in[I_BA]); auto pbx = launder(F.in[I_BX]); auto plam = launder(F.in[I_LAM]);
#pragma unroll
    for (int n = 0; n < 4; ++n) { const int ch = h * HD + n * 16 + c16; bav[n] = pba[ch]; bxv[n] = pbx[ch]; lamv[n] = plam[ch]; }
    {
        const int cp = F.tid & 255, half = F.tid >> 8, c0 = 2 * cp;
        float w0[4], w1[4];
#pragma unroll
        for (int k = 0; k < 4; ++k) { const f32x2 w = *(const f32x2*)(launder(F.in[I_LCW]) + k * LW + c0); w0[k] = w[0]; w1[k] = w[1]; }
        const f32x2 cb = *(const f32x2*)(launder(F.in[I_LCB]) + c0);
        const int tb = t0 + 32 * half;
        int o0 = first_valid - tb; o0 = o0 < 0 ? 0 : (o0 > 32 ? 32 : o0); o0 &= ~15;
        float x0[3], x1[3];
        auto rx_ld = [&](int tp, unsigned& v, float& ok) { const unsigned zo = zrow_off(b, tp, ok); v = *(const GAS unsigned*)(wsg + zo + 2 * (2 * CW + c0)); };
        if (o0 < 32) {
            { unsigned hv[3]; float hk[3];
#pragma unroll
              for (int i = 0; i < 3; ++i) rx_ld(tb + o0 - 3 + i, hv[i], hk[i]);
#pragma unroll
              for (int i = 0; i < 3; ++i) { x0[i] = hk[i] * bflo(hv[i]); x1[i] = hk[i] * bfhi(hv[i]); } }
#pragma unroll 1
            for (int ob = o0; ob < 32; ob += 16) {
                unsigned rv[16]; float rk[16];
#pragma unroll
                for (int i = 0; i < 16; ++i) rx_ld(tb + ob + i, rv[i], rk[i]);
                __builtin_amdgcn_sched_barrier(0);
#pragma unroll
                for (int i = 0; i < 16; ++i) {
                    const float n0 = rk[i] * bflo(rv[i]), n1 = rk[i] * bfhi(rv[i]);
                    const float a0 = cb[0] + w0[0] * x0[0] + w0[1] * x0[1] + w0[2] * x0[2] + w0[3] * n0;
                    const float a1 = cb[1] + w1[0] * x1[0] + w1[1] * x1[1] + w1[2] * x1[2] + w1[3] * n1;
                    *(LAS unsigned*)(xc + (32 * half + ob + i) * XC_STRIDE + c0) = pk2(a0, a1);
                    x0[0] = x0[1]; x0[1] = x0[2]; x0[2] = n0; x1[0] = x1[1]; x1[1] = x1[2]; x1[2] = n1;
                }
            }
        }
    }
    __syncthreads();
    float spv[4];
#pragma unroll
    for (int n = 0; n < 4; ++n) { const float nl = -lamv[n]; spv[n] = fmaxf(nl, 0.f) + log1pf(__expf(-fabsf(nl))); }
    const int chl = h * HD + lane;
    float hs = FINAL ? ((const LAS float*)(F.lds + LDS_CARRY))[chl] : 0.f, aprod = 1.f;
    for (int mt = 0; mt < 4; ++mt) {
        if (t0 + mt * 16 + 15 < first_valid) continue;
        f32x4 accR[4], accI[4];
#pragma unroll
        for (int n = 0; n < 4; ++n) { accR[n] = (f32x4){0.f, 0.f, 0.f, 0.f}; accI[n] = (f32x4){0.f, 0.f, 0.f, 0.f}; }
#pragma unroll
        for (int ks = 0; ks < 2; ++ks) {
            const bf16x8 A = *(const LAS bf16x8*)(xc + (mt * 16 + c16) * XC_STRIDE + h * HD + ks * 32 + 8 * q);
#pragma unroll
            for (int n = 0; n < 4; ++n) { accR[n] = __builtin_amdgcn_mfma_f32_16x16x32_bf16(A, Ba[n][ks], accR[n], 0, 0, 0); accI[n] = __builtin_amdgcn_mfma_f32_16x16x32_bf16(A, Bx[n][ks], accI[n], 0, 0, 0); }
        }
#pragma unroll
        for (int n = 0; n < 4; ++n)
#pragma unroll
            for (int r = 0; r < 4; ++r) {
                const int tl = mt * 16 + 4 * q + r;
                const float rg = sigmoidf_(accR[n][r] + bav[n]), ig = sigmoidf_(accI[n][r] + bxv[n]);
                const float la = -8.0f * rg * spv[n];
                const float a = __expf(la);
                const float om = fmaxf(fmaf(-a, a, 1.0f), 0.0f);
                float mult = __builtin_amdgcn_sqrtf(om);
                if (t0 + tl == start_tp) mult = 1.0f;
                const float xv = bf2f(xc[tl * XC_STRIDE + h * HD + n * 16 + c16]);
                ab[(4 * q + r) * 64 + n * 16 + c16] = (f32x2){a, mult * ig * xv};
            }
        float gv[16];
        if (FINAL) {
#pragma unroll
            for (int i = 0; i < 16; ++i) gv[i] = bf2f(F.Z[((size_t)b * SEQ + t0 + mt * 16 + i) * DIN + 3 * CW + chl]);
        }
        asm volatile("s_waitcnt lgkmcnt(0)" ::: "memory");
#pragma unroll
        for (int i = 0; i < 16; ++i) {
            const f32x2 v = ab[i * 64 + lane];
            if (t0 + mt * 16 + i >= first_valid) { hs = v[0] * hs + v[1]; aprod *= v[0]; }
            if (!FINAL && t0 >= 0) ((unsigned*)(F.ws + WS_AB))[((size_t)b * SEQ + t0 + mt * 16 + i) * LW + chl] = pk2(1.0f - v[0], v[1]);
            if (FINAL) F.MIX[((size_t)b * SEQ + t0 + mt * 16 + i) * D + CW + chl] = (bf16_t)f2bf(hs * gelu_tanh(gv[i]));
        }
        asm volatile("s_waitcnt lgkmcnt(0)" ::: "memory");
    }
    if (!FINAL) { sa[chl] = aprod; sh[chl] = hs; }
    __syncthreads();
}

__device__ __forceinline__ void p5_route_tile(Frame& F, int r0) {
    LAS float* atile = (LAS float*)(F.lds + F.wave * 4352);
    LAS float* plog = (LAS float*)(F.lds + 36864);
    LAS float* rstd_s = (LAS float*)(F.lds + 36864 + 16384);
    LAS int* sel_e = (LAS int*)(F.lds + 36864 + 16384 + 256);
    LAS float* sel_w = (LAS float*)(F.lds + 36864 + 16384 + 256 + 1024);
    LAS int* rank_s = (LAS int*)(F.lds + 36864 + 16384 + 256 + 2048);
    LAS int* lhist = (LAS int*)(F.lds + 36864 + 16384 + 256 + 3072);
    LAS int* lbase = (LAS int*)(F.lds + 36864 + 16384 + 256 + 3072 + 128);
    if (F.tid < NE) lhist[F.tid] = 0;
    {
        f32x4 gv[4];
#pragma unroll
        for (int j = 0; j < 4; ++j) gv[j] = *(const f32x4*)(F.in[I_GFFN] + 4 * F.lane + 256 * j);
#pragma unroll 1
        for (int hb = 0; hb < 2; ++hb) {
            f32x4 v[4][4]; float ss[4]; u32x2 hraw[4][4];
#pragma unroll
            for (int i = 0; i < 4; ++i)
#pragma unroll
                for (int j = 0; j < 4; ++j) hraw[i][j] = *(const u32x2*)(F.H1 + (size_t)(r0 + F.wave * 8 + hb * 4 + i) * D + 4 * F.lane + 256 * j);
            __builtin_amdgcn_sched_barrier(0);
#pragma unroll
            for (int i = 0; i < 4; ++i)
#pragma unroll
                for (int j = 0; j < 4; ++j) v[i][j] = (f32x4){bflo(hraw[i][j].x), bfhi(hraw[i][j].x), bflo(hraw[i][j].y), bfhi(hraw[i][j].y)};
#pragma unroll
            for (int i = 0; i < 4; ++i) { float s = 0.f;
#pragma unroll
                for (int j = 0; j < 4; ++j) s += (v[i][j][0] * v[i][j][0] + v[i][j][1] * v[i][j][1]) + (v[i][j][2] * v[i][j][2] + v[i][j][3] * v[i][j][3]);
                ss[i] = s; }
#pragma unroll
            for (int o = 1; o < 64; o <<= 1) {
#pragma unroll
                for (int i = 0; i < 4; ++i) ss[i] += __shfl_xor(ss[i], o); }
#pragma unroll
            for (int i = 0; i < 4; ++i) { const int rl = F.wave * 8 + hb * 4 + i; const float rstd = 1.0f / sqrtf(ss[i] * (1.0f / D) + NORM_EPS);
                if (F.lane == 0) rstd_s[rl] = rstd;
                const float sc = rstd * A8_SCALE;
#pragma unroll
                for (int j = 0; j < 4; ++j) *(unsigned*)(F.U1 + (size_t)(r0 + rl) * D + 4 * F.lane + 256 * j) = pk4_fp8(v[i][j][0] * sc * gv[j][0], v[i][j][1] * sc * gv[j][1], v[i][j][2] * sc * gv[j][2], v[i][j][3] * sc * gv[j][3]); }
        }
    }
    {
        const int mt = F.wave & 3, kh = F.wave >> 2, lane = F.lane, q = lane >> 4, c16 = lane & 15;
        f32x4 acc0 = (f32x4){0.f, 0.f, 0.f, 0.f}, acc1 = (f32x4){0.f, 0.f, 0.f, 0.f};
        const bf16_t* arow = F.H1 + (size_t)(r0 + mt * 16 + c16) * D + kh * 512 + 8 * q;
        const bf16_t* wr = (const bf16_t*)F.WR + (size_t)c16 * D + kh * 512 + 8 * q;
#pragma unroll 1
        for (int s0 = 0; s0 < 16; s0 += 4) {
            bf16x8 af[4], bh0[4], bh1[4], bl0[4], bl1[4];
#pragma unroll
            for (int s = 0; s < 4; ++s) { const int ko = 32 * (s0 + s);
                af[s] = *(const bf16x8*)(arow + ko);
                bh0[s] = *(const bf16x8*)(wr + ko); bh1[s] = *(const bf16x8*)(wr + 16 * D + ko);
                bl0[s] = *(const bf16x8*)(wr + NE * D + ko); bl1[s] = *(const bf16x8*)(wr + NE * D + 16 * D + ko); }
            __builtin_amdgcn_sched_barrier(0);
#pragma unroll
            for (int s = 0; s < 4; ++s) {
                acc0 = __builtin_amdgcn_mfma_f32_16x16x32_bf16(af[s], bh0[s], acc0, 0, 0, 0); acc0 = __builtin_amdgcn_mfma_f32_16x16x32_bf16(af[s], bl0[s], acc0, 0, 0, 0);
                acc1 = __builtin_amdgcn_mfma_f32_16x16x32_bf16(af[s], bh1[s], acc1, 0, 0, 0); acc1 = __builtin_amdgcn_mfma_f32_16x16x32_bf16(af[s], bl1[s], acc1, 0, 0, 0);
            }
        }
#pragma unroll
        for (int r = 0; r < 4; ++r) { plog[(kh * 64 + mt * 16 + 4 * q + r) * NE + c16] = acc0[r]; plog[(kh * 64 + mt * 16 + 4 * q + r) * NE + 16 + c16] = acc1[r]; }
    }
    __syncthreads();
    if (F.tid < 64) {
        const int t = F.tid; const float rs = rstd_s[t];
        float b0 = -3.0e38f, b1 = -3.0e38f, b2 = -3.0e38f, b3 = -3.0e38f; int i0 = 0, i1 = 0, i2 = 0, i3 = 0;
        for (int e = 0; e < NE; ++e) {
            const float v = (plog[t * NE + e] + plog[(64 + t) * NE + e]) * rs + F.in[I_BROUTER][e];
            if (v > b3) {
                if (v > b2) { b3 = b2; i3 = i2;
                    if (v > b1) { b2 = b1; i2 = i1;
                        if (v > b0) { b1 = b0; i1 = i0; b0 = v; i0 = e; } else { b1 = v; i1 = e; }
                    } else { b2 = v; i2 = e; }
                } else { b3 = v; i3 = e; }
            }
        }
        const float e0 = 1.0f, e1 = __expf(b1 - b0), e2 = __expf(b2 - b0), e3 = __expf(b3 - b0);
        const float inv = 1.0f / (e0 + e1 + e2 + e3);
        sel_e[t * 4 + 0] = i0; sel_e[t * 4 + 1] = i1; sel_e[t * 4 + 2] = i2; sel_e[t * 4 + 3] = i3;
        sel_w[t * 4 + 0] = e0 * inv; sel_w[t * 4 + 1] = e1 * inv; sel_w[t * 4 + 2] = e2 * inv; sel_w[t * 4 + 3] = e3 * inv;
    }
    __syncthreads();
    LAS int* wcnt = rank_s;
    int se = 0, rk = 0;
    if (F.tid < 256) {
        se = sel_e[F.tid]; unsigned long long mine = 0ull; int cnt_e = 0;
        for (int e = 0; e < NE; ++e) { const unsigned long long m = __ballot(se == e); if (se == e) mine = m; if (F.lane == e) cnt_e = __popcll(m); }
        rk = __popcll(mine & ((1ull << F.lane) - 1ull));
        if (F.lane < NE) wcnt[F.wave * NE + F.lane] = cnt_e;
    }
    __syncthreads();
    if (F.tid < 256) { for (int w = 0; w < F.wave; ++w) rk += wcnt[w * NE + se];
        const int pair = r0 * 4 + F.tid;
        __hip_atomic_store((int*)(F.ws + WS_PINFO) + pair, se | (rk << 8), __ATOMIC_RELAXED, __HIP_MEMORY_SCOPE_AGENT);
        __hip_atomic_store(F.GATEW + pair, sel_w[F.tid], __ATOMIC_RELAXED, __HIP_MEMORY_SCOPE_AGENT); }
    if (F.tid < NE) __hip_atomic_store((int*)(F.ws + WS_HIST) + (r0 / 64) * NE + F.tid, wcnt[F.tid] + wcnt[NE + F.tid] + wcnt[2 * NE + F.tid] + wcnt[3 * NE + F.tid], __ATOMIC_RELAXED, __HIP_MEMORY_SCOPE_AGENT);
    __syncthreads();
}

__device__ __forceinline__ void p5b_lists(Frame& F, int first, int stride) {
    LAS int* part = (LAS int*)F.lds;
    const int* hist = (const int*)(F.ws + WS_HIST); const int* pinfo = (const int*)(F.ws + WS_PINFO);
    for (int blk = first; blk < NTOK / 64; blk += stride) {
        { const int e = F.tid & 31, pt = F.tid >> 5; int sum = 0;
#pragma unroll
          for (int i = 0; i < 16; ++i) { const int b = pt + 16 * i; const int v = hist[b * NE + e]; sum += (b < blk) ? v : 0; }
          part[pt * NE + e] = sum; }
        __syncthreads();
        if (F.tid < NE) { int sum = 0; for (int pt = 0; pt < 16; ++pt) sum += part[pt * NE + F.tid]; part[512 + F.tid] = sum; }
        __syncthreads();
        if (F.tid < 256) { const int pair = blk * 256 + F.tid, info = pinfo[pair], e = info & 255, rk = info >> 8; const size_t pos = (size_t)e * NTOK + part[512 + e] + rk; F.LIST[pos] = pair; ((float*)(F.ws + WS_LISTG))[pos] = F.GATEW[pair]; }
        __syncthreads();
    }
}

__device__ __forceinline__ MoeSched moe_sched_build(Frame& F) {
    LAS int* cnt = (LAS int*)(F.lds + LDS_TAB); LAS int* tbase = cnt + 64;
    __syncthreads();
    { LAS int* part = cnt + 128; const int* hist = (const int*)(F.ws + WS_HIST); const int e = F.tid & 31, pt = F.tid >> 5; int sum = 0;
#pragma unroll
      for (int i = 0; i < 16; ++i) sum += hist[(pt + 16 * i) * NE + e];
      part[pt * NE + e] = sum; }
    __syncthreads();
    if (F.tid < NE) { int sum = 0; for (int pt = 0; pt < 16; ++pt) sum += cnt[128 + pt * NE + F.tid]; cnt[F.tid] = sum; }
    __syncthreads();
    if (F.tid == 0) { int s = 0; for (int e = 0; e < NE; ++e) { tbase[e] = s; s += (cnt[e] + BM - 1) / BM; } tbase[NE] = s; }
    __syncthreads();
    MoeSched M; M.cnt = cnt; M.tbase = tbase; M.G = F.G; M.vcu = F.vcu; return M;
}

__device__ __forceinline__ void p8_final(Frame& F) {
    f32x4 g0[2], g1[2];
#pragma unroll
    for (int hf = 0; hf < 2; ++hf) { const int k0 = hf * 512 + 8 * F.lane; g0[hf] = *(const f32x4*)(F.in[I_GFINAL] + k0); g1[hf] = *(const f32x4*)(F.in[I_GFINAL] + k0 + 4); }
#pragma unroll 1
    for (int m0 = F.gw; m0 < NTOK; m0 += 2 * F.NGW) {
        f32x4 ha[2][2], hb[2][2]; u32x2 yy[2][2][TOPK];
#pragma unroll
        for (int rr = 0; rr < 2; ++rr) { size_t m = (size_t)m0 + (size_t)rr * F.NGW; m = m < (size_t)NTOK ? m : (size_t)m0;
#pragma unroll
            for (int hf = 0; hf < 2; ++hf) { const int k0 = hf * 512 + 8 * F.lane;
                { const u32x4 hv = *(const u32x4*)(F.H1 + m * D + k0); ha[rr][hf] = (f32x4){bflo(hv[0]), bfhi(hv[0]), bflo(hv[1]), bfhi(hv[1])}; hb[rr][hf] = (f32x4){bflo(hv[2]), bfhi(hv[2]), bflo(hv[3]), bfhi(hv[3])}; }
#pragma unroll
                for (int k = 0; k < TOPK; ++k) yy[rr][hf][k] = *(const u32x2*)(F.Y + (m * TOPK + k) * D + k0); } }
        __builtin_amdgcn_sched_barrier(0);
#pragma unroll
        for (int rr = 0; rr < 2; ++rr) { const size_t m = (size_t)m0 + (size_t)rr * F.NGW; if (m >= (size_t)NTOK) continue;
            float v[16];
#pragma unroll
            for (int hf = 0; hf < 2; ++hf) {
                float acc8[8] = {0.f, 0.f, 0.f, 0.f, 0.f, 0.f, 0.f, 0.f};
#pragma unroll
                for (int k = 0; k < TOPK; ++k) {
                    const f32x2 p0 = __builtin_amdgcn_cvt_pk_f32_fp8((int)yy[rr][hf][k].x, false), p1 = __builtin_amdgcn_cvt_pk_f32_fp8((int)yy[rr][hf][k].x, true);
                    const f32x2 p2 = __builtin_amdgcn_cvt_pk_f32_fp8((int)yy[rr][hf][k].y, false), p3 = __builtin_amdgcn_cvt_pk_f32_fp8((int)yy[rr][hf][k].y, true);
                    acc8[0] += p0[0]; acc8[1] += p0[1]; acc8[2] += p1[0]; acc8[3] += p1[1]; acc8[4] += p2[0]; acc8[5] += p2[1]; acc8[6] += p3[0]; acc8[7] += p3[1]; }
#pragma unroll
                for (int j = 0; j < 4; ++j) { v[hf * 8 + j] = ha[rr][hf][j] + acc8[j] * (1.0f / Y8_SCALE); v[hf * 8 + 4 + j] = hb[rr][hf][j] + acc8[4 + j] * (1.0f / Y8_SCALE); }
            }
            float s = 0.f;
#pragma unroll
            for (int j = 0; j < 16; ++j) s += v[j] * v[j];
            const float rstd = 1.0f / sqrtf(wave_sum(s) * (1.0f / D) + NORM_EPS);
#pragma unroll
            for (int hf = 0; hf < 2; ++hf) { const int k0 = hf * 512 + 8 * F.lane;
                f32x4 o0, o1;
#pragma unroll
                for (int j = 0; j < 4; ++j) { o0[j] = v[hf * 8 + j] * rstd * g0[hf][j]; o1[j] = v[hf * 8 + 4 + j] * rstd * g1[hf][j]; }
                *(f32x4*)(F.out + m * D + k0) = o0; *(f32x4*)(F.out + m * D + k0 + 4) = o1; }
        }
    }
}

__device__ __forceinline__ void naive_p1(Frame& F) {
    for (long o = F.gw; o < (long)NTOK * DIN; o += F.NGW) { const int r = (int)(o / DIN), n = (int)(o % DIN);
        const float s = wave_dot_bf16(F.U0 + (size_t)r * D, F.WinT + (size_t)n * D, F.lane); if (F.lane == 0) F.Z[o] = (bf16_t)f2bf(s); }
}
__device__ __forceinline__ void naive_p4(Frame& F) {
    for (long o = F.gw; o < (long)NTOK * D; o += F.NGW) { const int r = (int)(o / D), n = (int)(o % D);
        const float s = wave_dot_bf16(F.MIX + (size_t)r * D, F.WoutT + (size_t)n * D, F.lane); if (F.lane == 0) F.H1[o] = (bf16_t)f2bf(F.in[I_X][o] + s); }
}

__global__ void __launch_bounds__(NTHREADS, 2) mk_fwd(Params p) {
    extern __shared__ __attribute__((aligned(16))) unsigned char lds_raw[];
    Frame F;
    F.lds = (LAS unsigned char*)lds_raw;
    F.tid = threadIdx.x; F.lane = F.tid & 63; F.wave = __builtin_amdgcn_readfirstlane(F.tid >> 6);
    F.G = gridDim.x; { const int bx = blockIdx.x; F.vcu = (F.G % 8 == 0) ? (bx % 8) * (F.G / 8) + bx / 8 : bx; }
    F.gw = F.vcu * NWAVES + F.wave; F.NGW = F.G * NWAVES;
#pragma unroll
    for (int i = 0; i < 24; ++i) F.in[i] = p.in[i];
    F.out = p.out; F.ws = p.ws; unsigned char* ws = p.ws;
    F.ctl = (unsigned*)(ws + WS_CTL);
    F.WinT = (bf16_t*)(ws + WS_WINT); F.WoutT = (bf16_t*)(ws + WS_WOUTT); F.WaT = (bf16_t*)(ws + WS_WAT); F.WxT = (bf16_t*)(ws + WS_WXT);
    F.WR = (float*)(ws + WS_WR); F.UMETA = (bf16_t*)(ws + WS_UMETA); F.ZMETA = (bf16_t*)(ws + WS_ZMETA); F.HMETA = (float*)(ws + WS_HMETA);
    F.SUMM = (float*)(ws + WS_SUMM); F.LIST = (int*)(ws + WS_LIST); F.GATEW = (float*)(ws + WS_GATEW);
    F.WguT = (fp8_t*)(ws + WS_WGUT); F.WdT = (fp8_t*)(ws + WS_WDT); F.U0 = (bf16_t*)(ws + WS_U0); F.Z = (bf16_t*)(ws + WS_Z);
    F.MIX = (bf16_t*)(ws + WS_MIX); F.H1 = (bf16_t*)(ws + WS_H1); F.U1 = (fp8_t*)(ws + WS_U1); F.ACT = (fp8_t*)(ws + WS_ACT); F.Y = (fp8_t*)(ws + WS_Y);

    volatile LAS unsigned* barw = (volatile LAS unsigned*)(F.lds + LDS_BARW);
    if (F.tid < 4) barw[F.tid] = 0u;
    __syncthreads();
    XcdBarrier bar; bar.bar = F.ctl + CW_BAR; bar.x = 0; bar.st = nullptr;
    if (MK_N_LAUNCHES == 1) bar = xcd_barrier_post(F.ctl + CW_BAR, barw);
    const int lo = p.ph_lo, hi = p.ph_hi;
#define IN(k) (((PH_MASK >> (k)) & 1) && lo <= (k) && (k) < hi)
#define SEAM(k) do { if (IN(k) && IN((k) + 1)) xcd_barrier(bar); } while (0)

    if (IN(0)) { p0_prologue(F); }
    SEAM(0);
    if (IN(1)) {
        if (NAIVE_MASK & 2) naive_p1(F);
        else { ProbIn P{F.U0, F.WinT, F.Z, F.G, (int)blockIdx.x}; gemm_phase<ProbIn, false>(F.lds, P); }
        p1_zmeta(F);
    }
    SEAM(1);
    if (IN(2)) {
        for (int it = F.vcu; it < NB * NTILE + 1; it += F.G) {
            if (it < NB * NTILE) {
                const int b = it / NTILE, j = it % NTILE;
#ifndef NO_CONF
                conformer_tile(F, b, j * TT);
                if (DBL_MASK & 1) conformer_tile(F, b, j * TT);
#endif
#ifndef NO_LRU
                float* s = F.SUMM + ((size_t)(b * NTILE + j) * 2) * LW;
                lru_tile<false>(F, b, j * TT, -1000000, -1000000, s, s + LW);
                if (DBL_MASK & 2) lru_tile<false>(F, b, j * TT, -1000000, -1000000, s, s + LW);
#endif
            } else {
#ifndef NO_LRU
                lru_tile<false>(F, 0, -TT, -NMETA, -NMETA, F.HMETA + LW, F.HMETA);
                if (DBL_MASK & 4) lru_tile<false>(F, 0, -TT, -NMETA, -NMETA, F.HMETA + LW, F.HMETA);
#endif
            }
        }
    }
    SEAM(2);
    if (IN(3)) {
        for (int it = F.vcu; it < NB * NTILE; it += F.G) {
            const int b = it / NTILE, j = it % NTILE, c = F.tid;
            float hc = F.HMETA[c];
            const size_t row0 = (size_t)b * SEQ + (size_t)j * TT;
            const unsigned* abp = (const unsigned*)(F.ws + WS_AB) + row0 * LW + c;
            const bf16_t* gp = F.Z + row0 * DIN + 3 * CW + c;
            bf16_t* mp = F.MIX + row0 * D + CW + c;
            unsigned ab[16]; unsigned short gr[16];
#pragma unroll
            for (int i = 0; i < 16; ++i) { ab[i] = abp[(size_t)i * LW]; gr[i] = gp[(size_t)i * DIN]; }
            { const float* sb = F.SUMM + ((size_t)b * NTILE * 2) * LW + c;
              int jj = 0;
              for (; jj + 8 <= j; jj += 8) { float av[8], hv[8];
#pragma unroll
                  for (int u = 0; u < 8; ++u) { av[u] = sb[(size_t)(jj + u) * 2 * LW]; hv[u] = sb[(size_t)(jj + u) * 2 * LW + LW]; }
#pragma unroll
                  for (int u = 0; u < 8; ++u) hc = av[u] * hc + hv[u]; }
              for (; jj < j; ++jj) hc = sb[(size_t)jj * 2 * LW] * hc + sb[(size_t)jj * 2 * LW + LW]; }
#pragma unroll 1
            for (int t0 = 0; t0 < TT; t0 += 16) {
                unsigned nab[16]; unsigned short ngr[16];
                if (t0 + 16 < TT) {
#pragma unroll
                    for (int i = 0; i < 16; ++i) { nab[i] = abp[(size_t)(t0 + 16 + i) * LW]; ngr[i] = gp[(size_t)(t0 + 16 + i) * DIN]; } }
                __builtin_amdgcn_sched_barrier(0);
#pragma unroll
                for (int i = 0; i < 16; ++i) { hc = (1.0f - bflo(ab[i])) * hc + bfhi(ab[i]); mp[(size_t)(t0 + i) * D] = (bf16_t)f2bf(hc * gelu_tanh(bf2f(gr[i]))); }
#pragma unroll
                for (int i = 0; i < 16; ++i) { ab[i] = nab[i]; gr[i] = ngr[i]; }
            }
        }
    }
    SEAM(3);
    if (IN(4)) {
        if (NAIVE_MASK & 16) naive_p4(F);
        else { ProbOut P{F.MIX, F.WoutT, F.in[I_X], F.H1, F.G, (int)blockIdx.x}; gemm_phase<ProbOut, false>(F.lds, P); }
    }
    SEAM(4);
    if (IN(5)) {
        constexpr int NITEM = NE * (D / 64) * (DIN / 64) + NE * (D / 64) * (D / 64);
        const int np = F.G >> 1, pr = F.vcu >> 1, nvw = np * NWAVES, rounds = (NITEM + nvw - 1) / nvw, ks = (rounds * CONV_SPLIT + 12) / 24;
        const bool router = (F.vcu & 1) != 0;
        if (router) {
            int nt = 0; for (int it = pr; it < NTOK / 64; it += np) { p5_route_tile(F, it * 64); ++nt; }
            asm volatile("s_waitcnt vmcnt(0)" ::: "memory"); __syncthreads();
            if (F.tid == 0) (void)xb_add(F.ctl + CW_RDONE, (unsigned)nt);
        }
#pragma unroll 1
        for (int seg = 0; seg < 2; ++seg) {
            const int k_lo = router ? (seg == 0 ? ks : ks + 1) : 0, k_hi = router ? (seg == 0 ? ks + 1 : rounds) : (seg == 0 ? ks : 0);
            expert_weights_to_fp8(F, pr * NWAVES + F.wave, nvw, k_lo, k_hi);
            if (seg == 0 && router) {
                if (F.tid == 0) { XB_SPIN(xb_ld(F.ctl + CW_RDONE) < (unsigned)(NTOK / 64), F.ctl + CW_BAR); __builtin_amdgcn_fence(__ATOMIC_ACQUIRE, "agent"); asm volatile("s_waitcnt vmcnt(0)" ::: "memory"); }
                __syncthreads();
                p5b_lists(F, pr, np);
            }
        }
    }
    SEAM(6);
    if (IN(7)) {
        const MoeSched M = moe_sched_build(F);
        { ProbGU P{F.U1, F.WguT, F.in[I_BGU], F.LIST, F.ACT, M}; gemm_phase<ProbGU, true>(F.lds, P); }
    }
    SEAM(7);
    if (IN(8)) {
        MoeSched M;
        if (MK_N_LAUNCHES == 1 && IN(7)) { LAS int* cnt = (LAS int*)(F.lds + LDS_TAB); M.cnt = cnt; M.tbase = cnt + 64; M.G = F.G; M.vcu = F.vcu; }
        else M = moe_sched_build(F);
        { ProbDown P{F.ACT, F.WdT, F.in[I_BD], F.LIST, (const float*)(F.ws + WS_LISTG), F.Y, M}; gemm_phase<ProbDown, true>(F.lds, P); }
    }
    SEAM(8);
    if (IN(9)) p8_final(F);
#undef IN
#undef SEAM
}
}

extern "C" void kernel_launch(void* const* d_in, const int* in_sizes, int n_in, void* d_out, int out_size, void* d_ws, size_t ws_size, hipStream_t stream) {
    using namespace mk;
    static int grid = 0;
    if (grid == 0) {
        if (n_in != 24 || out_size != NTOK * D || ws_size < WS_END) { fprintf(stderr, "kernel_launch: unexpected shapes (n_in %d out %d ws %zu)\n", n_in, out_size, ws_size); grid = -1; return; }
        int dev = 0, cus = 0, per_cu = 0;
        if (hipGetDevice(&dev) != hipSuccess || hipDeviceGetAttribute(&cus, hipDeviceAttributeMultiprocessorCount, dev) != hipSuccess) { grid = -1; return; }
        if (hipFuncSetAttribute((const void*)mk_fwd, hipFuncAttributeMaxDynamicSharedMemorySize, LDS_BYTES) != hipSuccess) { fprintf(stderr, "kernel_launch: hipFuncSetAttribute failed\n"); grid = -1; return; }
        if (hipOccupancyMaxActiveBlocksPerMultiprocessor(&per_cu, (const void*)mk_fwd, NTHREADS, LDS_BYTES) != hipSuccess || per_cu < 1) { fprintf(stderr, "kernel_launch: occupancy query says %d\n", per_cu); grid = -1; return; }
        grid = cus & ~1;
    }
    if (grid <= 0) return;
    (void)in_sizes;
    (void)hipMemsetAsync((char*)d_ws + WS_CTL, 0, CTL_ZERO_BYTES, stream);
    Params p{};
    for (int i = 0; i < 24; ++i) p.in[i] = (const float*)d_in[i];
    p.out = (float*)d_out; p.ws = (unsigned char*)d_ws;
    if (MK_N_LAUNCHES == 1) { p.ph_lo = 0; p.ph_hi = 10; hipLaunchKernelGGL(mk_fwd, dim3(grid), dim3(NTHREADS), LDS_BYTES, stream, p); }
    else { for (int ph = 0; ph < 10; ++ph) { p.ph_lo = ph; p.ph_hi = ph + 1;
            for (int rep = 0; rep < 1 + ((REP_MASK >> ph) & 1); ++rep) {
                hipLaunchKernelGGL(mk_fwd, dim3(grid), dim3(NTHREADS), LDS_BYTES, stream, p); } } }
}
```

```cpp
#include <hip/hip_runtime.h>
#include <stdint.h>
#include <stdio.h>

#ifndef MK_N_LAUNCHES
#define MK_N_LAUNCHES 1
#endif
#ifndef PH_MASK
#define PH_MASK 0x3ff
#endif
#ifndef REP_MASK
#define REP_MASK 0
#endif
#ifndef DBL_MASK
#define DBL_MASK 0
#endif
#ifndef NAIVE_MASK
#define CONV_SPLIT 19
#define NAIVE_MASK 0
#endif

#define GAS __attribute__((address_space(1)))
#define LAS __attribute__((address_space(3)))
typedef unsigned short bf16_t;
typedef short bf16x8 __attribute__((ext_vector_type(8)));
typedef float f32x4 __attribute__((ext_vector_type(4)));
typedef float f32x2 __attribute__((ext_vector_type(2)));
typedef unsigned u32x4 __attribute__((ext_vector_type(4)));
typedef unsigned u32x2 __attribute__((ext_vector_type(2)));
typedef int i32x4 __attribute__((ext_vector_type(4)));
typedef int i32x8 __attribute__((ext_vector_type(8)));
typedef unsigned char fp8_t;

namespace mk {
constexpr int D = 1024, NB = 4, SEQ = 4096, NTOK = NB * SEQ, NMETA = 16;
constexpr int CW = 512, LW = 512, DIN = 2048, CK = 31, NE = 32, TOPK = 4, NH = 8, HD = 64;
constexpr int NPAIR = NTOK * TOPK;
constexpr int ACT_ROWS = NPAIR + NE * 256;
constexpr int NTHREADS = 512, NWAVES = 8;
constexpr int TT = 64;
constexpr int NTILE = SEQ / TT;
constexpr float NORM_EPS = 1e-6f, LN_EPS = 1e-5f;

constexpr size_t MiB = 1u << 20, KiB = 1u << 10;
constexpr int ZPAD = 32, ZB = SEQ + ZPAD;
constexpr size_t WS_CTL = 0, CTL_ZERO_BYTES = 64 * KiB;
constexpr size_t WS_WINT = 1 * MiB;
constexpr size_t WS_WOUTT = 5 * MiB;
constexpr size_t WS_WAT = 7 * MiB;
constexpr size_t WS_WXT = 7 * MiB + 64 * KiB;
constexpr size_t WS_WR = 7 * MiB + 128 * KiB;
constexpr size_t WS_UMETA = 7 * MiB + 256 * KiB;
constexpr size_t WS_ZMETA = 7 * MiB + 320 * KiB;
constexpr size_t WS_HMETA = 7 * MiB + 384 * KiB;
constexpr size_t WS_SUMM = 8 * MiB;
constexpr size_t WS_LIST = 9 * MiB;
constexpr size_t WS_GATEW = 11 * MiB;
constexpr size_t WS_HIST = 11 * MiB + 512 * KiB;
constexpr size_t WS_LISTG = 13 * MiB;
constexpr size_t WS_PINFO = 12 * MiB;
constexpr size_t WS_WGUT = 16 * MiB;
constexpr size_t WS_WDT = 144 * MiB;
constexpr size_t WS_U0 = 208 * MiB;
constexpr size_t WS_Z = 704 * MiB;
constexpr size_t WS_MIX = 304 * MiB;
constexpr size_t WS_H1 = 336 * MiB;
constexpr size_t WS_U1 = 400 * MiB;
constexpr size_t WS_ACT = 432 * MiB;
constexpr size_t WS_Y = 576 * MiB;
constexpr size_t WS_AB = 640 * MiB;
constexpr size_t WS_END = 772 * MiB;
constexpr int CW_BAR = 4096;
constexpr int CW_RDONE = 12288;
constexpr int CW_CNT = 8192;

constexpr int LDS_BYTES = 147456;
constexpr int LDS_TAB = 135168;
constexpr int LDS_IDS = 144384;
constexpr int LDS_PF = 138240, PF_BYTES = 3072;
constexpr int LDS_BARW = LDS_BYTES - 64;

__device__ __forceinline__ unsigned pk2(float lo, float hi) { unsigned r; asm("v_cvt_pk_bf16_f32 %0, %1, %2" : "=v"(r) : "v"(lo), "v"(hi)); return r; }
__device__ __forceinline__ unsigned f2bf(float f) { return pk2(f, f) & 0xffffu; }
__device__ __forceinline__ float bf2f(unsigned b) { return __uint_as_float(b << 16); }
__device__ __forceinline__ float bflo(unsigned w) { return __uint_as_float(w << 16); }
__device__ __forceinline__ float bfhi(unsigned w) { return __uint_as_float(w & 0xffff0000u); }
__device__ __forceinline__ unsigned pk4_fp8(float a, float b, float c, float d) { int w = 0; w = __builtin_amdgcn_cvt_pk_fp8_f32(a, b, w, false); w = __builtin_amdgcn_cvt_pk_fp8_f32(c, d, w, true); return (unsigned)w; }
constexpr float W8_SCALE = 64.0f, A8_SCALE = 4.0f, Y8_SCALE = 16.0f;
constexpr int W8_E8M0 = 0x79797979, A8_E8M0 = 0x7d7d7d7d;
template <int CTRL> __device__ __forceinline__ float dpp_add(float v) { return v + __builtin_bit_cast(float, __builtin_amdgcn_update_dpp(0, __builtin_bit_cast(int, v), CTRL, 0xf, 0xf, true)); }
__device__ __forceinline__ float wave_sum(float v) {
    v = dpp_add<0xB1>(v); v = dpp_add<0x4E>(v); v = dpp_add<0x141>(v); v = dpp_add<0x140>(v);
    const int iv = __builtin_bit_cast(int, v);
    const float r0 = __builtin_bit_cast(float, __builtin_amdgcn_readlane(iv, 0)), r1 = __builtin_bit_cast(float, __builtin_amdgcn_readlane(iv, 16));
    const float r2 = __builtin_bit_cast(float, __builtin_amdgcn_readlane(iv, 32)), r3 = __builtin_bit_cast(float, __builtin_amdgcn_readlane(iv, 48));
    return (r0 + r1) + (r2 + r3);
}
__device__ __forceinline__ float sigmoidf_(float x) { return __builtin_amdgcn_rcpf(1.0f + __expf(-x)); }
__device__ __forceinline__ float gelu_tanh(float x) {
    const float u = 0.7978845608028654f * (x + 0.044715f * x * x * x);
    const float t = 1.0f - 2.0f * __builtin_amdgcn_rcpf(1.0f + __expf(2.0f * u));
    return 0.5f * x * (1.0f + t);
}

#define XB_TMO      128
#define XB_XCNT(j)  (256  + 64 * (j))
#define XB_XSUB(j)  (1280 + 64 * (j))
#define XB_XGEN(j)  (2304 + 64 * (j))
#define XB_TOP      3328
#define XB_TOPGEN   3392
#define XCD_BAR_WORDS 3456
#define XB_SPIN_CAP (1u << 18)

__device__ __forceinline__ unsigned xb_ld(unsigned* p)              { return __hip_atomic_load(p, __ATOMIC_RELAXED, __HIP_MEMORY_SCOPE_AGENT); }
__device__ __forceinline__ unsigned xb_add(unsigned* p, unsigned v) { return __hip_atomic_fetch_add(p, v, __ATOMIC_RELAXED, __HIP_MEMORY_SCOPE_AGENT); }
__device__ __forceinline__ unsigned xb_xcc_id() { return (unsigned)__builtin_amdgcn_s_getreg((3 << 11) | 20) & 0xFu; }
#define XB_SPIN(cond, bar) do { unsigned _sp = 0; while (cond) { __builtin_amdgcn_s_sleep(1); \
    if ((++_sp & 255u) == 0u) { if (xb_ld(&(bar)[XB_TMO])) break; if (_sp > XB_SPIN_CAP) { atomicAdd(&(bar)[XB_TMO], 1u); break; } } } } while (0)

struct XcdBarrier {
    unsigned* bar; unsigned x;
    volatile LAS unsigned* st;
};
__device__ __forceinline__ XcdBarrier xcd_barrier_post(unsigned* bar, volatile LAS unsigned* st) {
    XcdBarrier b; b.bar = bar; b.x = xb_xcc_id(); b.st = st;
    if (threadIdx.x == 0) (void)xb_add(&bar[XB_XCNT(b.x)], 1u);
    return b;
}
__device__ __forceinline__ void xcd_barrier_complete(unsigned* bar, unsigned x, unsigned& nloc, unsigned& nx) {
    const unsigned G = gridDim.x * gridDim.y * gridDim.z;
    unsigned sum, cnt, mine, sp = 0u;
    for (;;) {
        sum = 0u; cnt = 0u; mine = 0u;
#pragma unroll
        for (unsigned j = 0; j < 16; ++j) { const unsigned c = xb_ld(&bar[XB_XCNT(j)]); sum += c; cnt += (c > 0u) ? 1u : 0u; mine = (j == x) ? c : mine; }
        if (sum == G) break;
        __builtin_amdgcn_s_sleep(1);
        if ((++sp & 255u) == 0u) { if (xb_ld(&bar[XB_TMO])) break; if (sp > XB_SPIN_CAP) { atomicAdd(&bar[XB_TMO], 1u); break; } }
    }
    nloc = mine > 0u ? mine : 1u; nx = cnt > 0u ? cnt : 1u;
}
__device__ __forceinline__ void xcd_barrier(const XcdBarrier& b) {
    asm volatile("s_waitcnt vmcnt(0)" ::: "memory");
    __syncthreads();
    if (threadIdx.x == 0) {
        unsigned* bar = b.bar;
        __builtin_amdgcn_s_waitcnt(0);
        unsigned nloc = b.st[0], nx = b.st[1];
        if (nloc == 0u) { xcd_barrier_complete(bar, b.x, nloc, nx); b.st[0] = nloc; b.st[1] = nx; }
        const unsigned old = xb_add(&bar[XB_XSUB(b.x)], 1u);
        const unsigned gen = old / nloc;
        if (old + 1u == (gen + 1u) * nloc) {
            __builtin_amdgcn_fence(__ATOMIC_RELEASE, "agent");
            asm volatile("s_waitcnt vmcnt(0)" ::: "memory");
            const unsigned og = xb_add(&bar[XB_TOP], 1u);
            const unsigned tg = og / nx;
            if (og + 1u == (tg + 1u) * nx) xb_add(&bar[XB_TOPGEN], 1u);
            else XB_SPIN(xb_ld(&bar[XB_TOPGEN]) == tg, bar);
            __builtin_amdgcn_fence(__ATOMIC_ACQUIRE, "agent");
            xb_add(&bar[XB_XGEN(b.x)], 1u);
            asm volatile("s_waitcnt vmcnt(0)" ::: "memory");
        } else {
            XB_SPIN(xb_ld(&bar[XB_XGEN(b.x)]) == gen, bar);
            __builtin_amdgcn_fence(__ATOMIC_ACQUIRE, "agent");
            asm volatile("s_waitcnt vmcnt(0)" ::: "memory");
        }
    }
    __syncthreads();
}

struct Params {
    const float* in[24];
    float* out;
    unsigned char* ws;
    int ph_lo, ph_hi;
};
enum { I_X = 0, I_META, I_GMIX, I_WIN, I_CDW, I_CDB, I_CLNG, I_CLNB, I_LCW, I_LCB, I_WA, I_BA, I_WX, I_BX, I_LAM, I_WOUT, I_GFFN, I_WROUTER, I_BROUTER, I_WGU, I_BGU, I_WD, I_BD, I_GFINAL };

constexpr int BM = 256, BK = 64, HALF = 128, HTB = HALF * BK * 2, STAGE_BYTES = 8 * HTB, GK = 1024;
__device__ __forceinline__ int lds_byte(int r, int c) { const int st = (r >> 4) * 2 + (c >> 5), rr = r & 15, cc = c & 31, ob = rr * 64 + cc * 2; return st * 1024 + (ob ^ (((ob >> 9) & 1) << 5)); }
__device__ __forceinline__ void stage_rc(int b, int& R, int& C) { const int st = b / 1024, sb = b % 1024, swz = sb ^ (((sb >> 9) & 1) << 5); R = (st >> 1) * 16 + swz / 64; C = (st & 1) * 32 + (swz % 64) / 2; }
__device__ __forceinline__ int perm32(int rho) { const int n = rho >> 4, i = rho & 15; return 8 * (i >> 2) + 4 * n + (i & 3); }
__device__ __forceinline__ unsigned cvt_pk_bf16(float lo, float hi) { unsigned r; asm volatile("v_cvt_pk_bf16_f32 %0, %1, %2" : "=v"(r) : "v"(lo), "v"(hi)); return r; }

template <class T> __device__ __forceinline__ T* launder(T* p) { asm volatile("" : "+s"(p)); return p; }
struct Unit { int pm, pn, e, rows, rt; };
__device__ __forceinline__ void mfma_fp8_inplace(f32x4& acc, const i32x8& w, const i32x8& x, int sw, int sx) {
    asm volatile("v_mfma_scale_f32_16x16x128_f8f6f4 %0, %1, %2, %0, %3, %4 op_sel_hi:[0,0,0]" : "+v"(acc) : "v"(w), "v"(x), "v"(sw), "v"(sx));
}

template <class P, bool FP8>
__device__ __forceinline__ void gemm_phase(LAS unsigned char* lds, const P& S) {
    const int tid = threadIdx.x, wid = __builtin_amdgcn_readfirstlane(tid >> 6), lane = tid & 63, wr = wid >> 2, wc = wid & 3, fr = lane & 15, fq = lane >> 4;
    constexpr int K = GK, KB = FP8 ? K : 2 * K  , nt = KB / (BK * 2);
    constexpr bool GATHER = P::GATHER;
    unsigned voffB[2], voffA[2], c2 = 0;
#pragma unroll
    for (int i = 0; i < 2; ++i) { int pR, pC; stage_rc(tid * 16 + i * 8192, pR, pC); const int Rb = P::PERM ? ((pR & ~31) + perm32(pR & 31)) : pR; voffB[i] = (unsigned)(Rb * KB + pC * 2); voffA[i] = (unsigned)(pR * KB + pC * 2); c2 = (unsigned)(pC * 2); }
    const size_t kstep = (size_t)(BK * 2);
    const size_t hstep = (size_t)HALF * KB;
    const unsigned ldsw = (unsigned)wid * 1024u;
    const int aoff = lds_byte(wr * 64 + fr, fq * 8), boff = lds_byte(wc * 32 + fr, fq * 8);
#define PG8_SA(b, h) (((b) * 2 + (h)) * HTB)
#define PG8_SB(b, h) ((4 + (b) * 2 + (h)) * HTB)
#define PG8_STAGE(bufoff, gbase, voff) do { _Pragma("unroll") for (int _i = 0; _i < 2; ++_i) \
        __builtin_amdgcn_global_load_lds((const unsigned*)((const char*)(gbase) + (voff)[_i]), (LAS unsigned*)(lds + (bufoff) + ldsw + _i * 8192), 16, 0, 0); } while (0)
#define PG8_STAGE_A(bufoff, gbase, h, PK) do { _Pragma("unroll") for (int _i = 0; _i < 2; ++_i) { \
        if constexpr (GATHER) { const unsigned _o = (((PK)[h] >> (16 * _i)) & 0xffffu) * (unsigned)KB + c2; \
            __builtin_amdgcn_global_load_lds((const unsigned*)((const char*)(gbase) + _o), (LAS unsigned*)(lds + (bufoff) + ldsw + _i * 8192), 16, 0, 0); } \
        else __builtin_amdgcn_global_load_lds((const unsigned*)((const char*)(gbase) + (h) * hstep + voffA[_i]), (LAS unsigned*)(lds + (bufoff) + ldsw + _i * 8192), 16, 0, 0); } } while (0)
#define PG8_LDA(dst, b, h) do { _Pragma("unroll") for (int m = 0; m < 4; ++m) { \
        if constexpr (FP8) { const i32x4 lo_ = *(const LAS i32x4*)(lds + PG8_SA(b, h) + aoff + m * 2048), hi_ = *(const LAS i32x4*)(lds + PG8_SA(b, h) + aoff + m * 2048 + 1024); dst##8[m] = __builtin_shufflevector(lo_, hi_, 0, 1, 2, 3, 4, 5, 6, 7); } \
        else { _Pragma("unroll") for (int k = 0; k < 2; ++k) dst[m][k] = *(const LAS bf16x8*)(lds + PG8_SA(b, h) + aoff + m * 2048 + k * 1024); } } } while (0)
#define PG8_LDB(dst, b, h) do { _Pragma("unroll") for (int n = 0; n < 2; ++n) { \
        if constexpr (FP8) { const i32x4 lo_ = *(const LAS i32x4*)(lds + PG8_SB(b, h) + boff + n * 2048), hi_ = *(const LAS i32x4*)(lds + PG8_SB(b, h) + boff + n * 2048 + 1024); dst##8[n] = __builtin_shufflevector(lo_, hi_, 0, 1, 2, 3, 4, 5, 6, 7); } \
        else { _Pragma("unroll") for (int k = 0; k < 2; ++k) dst[n][k] = *(const LAS bf16x8*)(lds + PG8_SB(b, h) + boff + n * 2048 + k * 1024); } } } while (0)
#define PG8_MMA(ai, bj, At, Bt) do { __builtin_amdgcn_s_setprio(1); _Pragma("unroll") for (int m = 0; m < 4; ++m) _Pragma("unroll") for (int n = 0; n < 2; ++n) { \
        if constexpr (FP8) mfma_fp8_inplace(acc[ai][bj][m][n], Bt##8[n], At##8[m], sc_w, sc_x); \
        else { _Pragma("unroll") for (int k = 0; k < 2; ++k) acc[ai][bj][m][n] = __builtin_amdgcn_mfma_f32_16x16x32_bf16(Bt[n][k], At[m][k], acc[ai][bj][m][n], 0, 0, 0); } } \
        __builtin_amdgcn_s_setprio(0); } while (0)
#define PG8_WAIT_V(n) asm volatile("s_waitcnt vmcnt(" #n ")" ::: "memory")
#define PG8_WAIT_L(n) asm volatile("s_waitcnt lgkmcnt(" #n ")" ::: "memory")
#define PG8_BAR __builtin_amdgcn_s_barrier()
#define PG8_SCHED __builtin_amdgcn_sched_barrier(0)
    Unit cur, nxt; int ui = 0;
    if (!S.next(0, cur)) return;
    unsigned cpk[2] = {0u, 0u}, npk[2] = {0u, 0u};
    if constexpr (GATHER) S.a_rows(cur, cpk);
    bool has_next = S.next(1, nxt);
    if constexpr (GATHER) { npk[0] = cpk[0]; npk[1] = cpk[1]; if (has_next) S.ids_prefetch(nxt, lds + LDS_IDS + 1024, wid, lane); }
    f32x4 acc[2][2][4][2];
#pragma unroll
    for (int a = 0; a < 2; ++a)
#pragma unroll
        for (int b = 0; b < 2; ++b)
#pragma unroll
            for (int m = 0; m < 4; ++m)
#pragma unroll
                for (int n = 0; n < 2; ++n) acc[a][b][m][n] = (f32x4){0.f, 0.f, 0.f, 0.f};
    bf16x8 At[4][2], B0[2][2], B1[2][2]; i32x8 At8[4], B08[2], B18[2];
    int sc_w = W8_E8M0, sc_x = A8_E8M0; asm volatile("" : "+v"(sc_w), "+v"(sc_x));
    const char* cA = S.a_base(cur); const char* cB = S.b_base(cur);
    S.prefetch(cur, lds + LDS_PF, wid, lane);
    PG8_STAGE(PG8_SB(0, 0), cB, voffB); PG8_STAGE_A(PG8_SA(0, 0), cA, 0, cpk); PG8_STAGE(PG8_SB(0, 1), cB + hstep, voffB); PG8_STAGE_A(PG8_SA(0, 1), cA, 1, cpk);
    if (wr == 1) PG8_BAR;
    PG8_WAIT_V(4); PG8_BAR;
    PG8_STAGE(PG8_SB(1, 0), cB + kstep, voffB); PG8_STAGE_A(PG8_SA(1, 0), cA + kstep, 0, cpk); PG8_STAGE(PG8_SB(1, 1), cB + hstep + kstep, voffB);
    PG8_WAIT_V(6); PG8_BAR;
    for (;;) {
        const char* nA = has_next ? S.a_base(nxt) : cA; const char* nB = has_next ? S.b_base(nxt) : cB;
#pragma unroll 1
        for (int t = 0; t < nt; t += 2) {
            const bool last = (t == nt - 2);
            const char* a1 = cA + (size_t)(t + 1) * kstep;
            const char* a2 = last ? nA : cA + (size_t)(t + 2) * kstep; const char* b2 = last ? nB : cB + (size_t)(t + 2) * kstep;
            const char* a3 = a2 + kstep; const char* b3 = b2 + kstep;
            if constexpr (GATHER) { if (last && has_next) S.ids_read(nxt, lds + LDS_IDS + ((ui + 1) & 1) * 1024, npk); }
            PG8_LDB(B0, 0, 0); PG8_SCHED; PG8_LDA(At, 0, 0); PG8_STAGE_A(PG8_SA(1, 1), a1, 1, cpk);
            if constexpr (GATHER) { if (last) { cpk[0] = npk[0]; cpk[1] = npk[1]; } }
            PG8_WAIT_L(8); PG8_BAR; PG8_WAIT_L(0); PG8_MMA(0, 0, At, B0); PG8_BAR; PG8_SCHED;
            PG8_LDB(B1, 0, 1); PG8_STAGE(PG8_SB(0, 0), b2, voffB);
            PG8_BAR; PG8_WAIT_L(0); PG8_MMA(0, 1, At, B1); PG8_BAR;
            PG8_LDA(At, 0, 1); PG8_STAGE_A(PG8_SA(0, 0), a2, 0, cpk);
            PG8_BAR; PG8_WAIT_L(0); PG8_MMA(1, 0, At, B0); PG8_BAR; PG8_SCHED;
            PG8_STAGE(PG8_SB(0, 1), b2 + hstep, voffB);
            PG8_WAIT_V(6); PG8_BAR; PG8_MMA(1, 1, At, B1); PG8_BAR;
            PG8_LDB(B0, 1, 0); PG8_SCHED; PG8_LDA(At, 1, 0); PG8_STAGE_A(PG8_SA(0, 1), a2, 1, cpk);
            PG8_WAIT_L(8); PG8_BAR; PG8_WAIT_L(0); PG8_MMA(0, 0, At, B0); PG8_BAR; PG8_SCHED;
            PG8_LDB(B1, 1, 1); PG8_STAGE(PG8_SB(1, 0), b3, voffB);
            PG8_BAR; PG8_WAIT_L(0); PG8_MMA(0, 1, At, B1); PG8_BAR;
            PG8_LDA(At, 1, 1); PG8_STAGE_A(PG8_SA(1, 0), a3, 0, cpk);
            PG8_BAR; PG8_WAIT_L(0); PG8_MMA(1, 0, At, B0); PG8_BAR; PG8_SCHED;
            PG8_STAGE(PG8_SB(1, 1), b3 + hstep, voffB);
            PG8_WAIT_V(6); PG8_BAR; PG8_MMA(1, 1, At, B1); PG8_BAR;
        }
        if constexpr (FP8) {
#pragma unroll
            for (int a = 0; a < 2; ++a)
#pragma unroll
                for (int b = 0; b < 2; ++b)
                    asm volatile("s_nop 15\n\ts_nop 15" : "+v"(acc[a][b][0][0]), "+v"(acc[a][b][0][1]), "+v"(acc[a][b][1][0]), "+v"(acc[a][b][1][1]), "+v"(acc[a][b][2][0]), "+v"(acc[a][b][2][1]), "+v"(acc[a][b][3][0]), "+v"(acc[a][b][3][1]) :: "memory");
        }
        Unit nn = nxt; const bool has_nn = has_next ? S.next(ui + 2, nn) : false;
        S.epi(acc, cur, wr, wc, fr, fq, lds + LDS_PF + (ui & 1) * PF_BYTES);
        if (!has_next) break;
#pragma unroll
        for (int a = 0; a < 2; ++a)
#pragma unroll
            for (int b = 0; b < 2; ++b)
#pragma unroll
                for (int m = 0; m < 4; ++m)
#pragma unroll
                    for (int n = 0; n < 2; ++n) acc[a][b][m][n] = (f32x4){0.f, 0.f, 0.f, 0.f};
        cur = nxt; cA = nA; cB = nB; ++ui;
        S.prefetch(cur, lds + LDS_PF + (ui & 1) * PF_BYTES, wid, lane);
        nxt = nn; has_next = has_nn;
        if constexpr (GATHER) { if (has_next) S.ids_prefetch(nxt, lds + LDS_IDS + ((ui + 1) & 1) * 1024, wid, lane); }
    }
    PG8_WAIT_V(0);
    if (wr == 0) PG8_BAR;
    PG8_BAR;
#undef PG8_SA
#undef PG8_SB
#undef PG8_STAGE
#undef PG8_STAGE_A
#undef PG8_LDA
#undef PG8_LDB
#undef PG8_MMA
#undef PG8_WAIT_V
#undef PG8_WAIT_L
#undef PG8_BAR
#undef PG8_SCHED
}

__device__ __forceinline__ bool static_next(int i, int G, int c, int nM, int nN, Unit& u) {
    const int nwg = nM * nN; const long L = (long)i * G + c; if (L >= nwg) return false;
    int wgid = (int)L; { const int q = nwg / 8, r = nwg % 8, xcd = wgid % 8, off = wgid / 8; wgid = (xcd < r ? xcd * (q + 1) : r * (q + 1) + (xcd - r) * q) + off; }
    const int nig = 8 * nN, gid = wgid / nig, fm = gid * 8, gsz = (nM - fm) < 8 ? (nM - fm) : 8;
    u.pm = fm + ((wgid % nig) % gsz); u.pn = (wgid % nig) / gsz; u.e = 0; u.rows = 256; u.rt = u.pm; return true;
}

struct ProbIn {
    static constexpr bool PERM = true, GATHER = false;
    const bf16_t* A; const bf16_t* Bt; bf16_t* O; int G, c;
    __device__ __forceinline__ bool next(int i, Unit& u) const { return static_next(i, G, c, NTOK / BM, DIN / BM, u); }
    __device__ __forceinline__ void prefetch(const Unit&, LAS unsigned char*, int, int) const {}
    __device__ __forceinline__ const char* a_base(const Unit& u) const { return (const char*)A + (size_t)u.pm * BM * GK * 2; }
    __device__ __forceinline__ const char* b_base(const Unit& u) const { return (const char*)Bt + (size_t)u.pn * BM * GK * 2; }
    __device__ __forceinline__ void epi(const f32x4 (&acc)[2][2][4][2], const Unit& u, int wr, int wc, int fr, int fq, const LAS unsigned char* pf) const {
        int row0 = u.pm * BM + wr * 64 + fr, col0 = u.pn * BM + wc * 64 + 8 * fq;
        asm volatile("" : "+v"(row0), "+v"(col0));
        auto Ob = launder(O);
#pragma unroll
        for (int ai = 0; ai < 2; ++ai)
#pragma unroll
            for (int m = 0; m < 4; ++m) { auto rowp = Ob + (size_t)(row0 + ZPAD * (u.pm / (SEQ / BM) + 1) + ai * HALF + m * 16) * DIN + col0;
#pragma unroll
                for (int bj = 0; bj < 2; ++bj) { const f32x4 v0 = acc[ai][bj][m][0], v1 = acc[ai][bj][m][1];
                    u32x4 w; w.x = cvt_pk_bf16(v0[0], v0[1]); w.y = cvt_pk_bf16(v0[2], v0[3]); w.z = cvt_pk_bf16(v1[0], v1[1]); w.w = cvt_pk_bf16(v1[2], v1[3]);
                    *(u32x4*)(rowp + bj * 32) = w; } }
    }
};
struct ProbOut {
    static constexpr bool PERM = true, GATHER = false;
    const bf16_t* A; const bf16_t* Bt; const float* X; bf16_t* O; int G, c;
    __device__ __forceinline__ bool next(int i, Unit& u) const { return static_next(i, G, c, NTOK / BM, D / BM, u); }
    __device__ __forceinline__ void prefetch(const Unit&, LAS unsigned char*, int, int) const {}
    __device__ __forceinline__ const char* a_base(const Unit& u) const { return (const char*)A + (size_t)u.pm * BM * GK * 2; }
    __device__ __forceinline__ const char* b_base(const Unit& u) const { return (const char*)Bt + (size_t)u.pn * BM * GK * 2; }
    __device__ __forceinline__ void epi(const f32x4 (&acc)[2][2][4][2], const Unit& u, int wr, int wc, int fr, int fq, const LAS unsigned char* pf) const {
        int row0 = u.pm * BM + wr * 64 + fr, col0 = u.pn * BM + wc * 32 + 8 * fq;
        asm volatile("" : "+v"(row0), "+v"(col0));
        auto Xb = launder(X); auto Ob = launder(O);
#pragma unroll
        for (int ai = 0; ai < 2; ++ai) {
            f32x4 xv[4][2][2];
#pragma unroll
            for (int m = 0; m < 4; ++m) { const size_t ro = (size_t)(row0 + ai * HALF + m * 16) * D + col0;
#pragma unroll
                for (int bj = 0; bj < 2; ++bj)
#pragma unroll
                    for (int n = 0; n < 2; ++n) xv[m][bj][n] = *(const f32x4*)(Xb + ro + bj * HALF + n * 4); }
            __builtin_amdgcn_sched_barrier(0);
#pragma unroll
            for (int m = 0; m < 4; ++m) { const size_t ro = (size_t)(row0 + ai * HALF + m * 16) * D + col0;
#pragma unroll
                for (int bj = 0; bj < 2; ++bj) { const f32x4 v0 = acc[ai][bj][m][0] + xv[m][bj][0], v1 = acc[ai][bj][m][1] + xv[m][bj][1];
                    u32x4 w; w.x = cvt_pk_bf16(v0[0], v0[1]); w.y = cvt_pk_bf16(v0[2], v0[3]); w.z = cvt_pk_bf16(v1[0], v1[1]); w.w = cvt_pk_bf16(v1[2], v1[3]);
                    *(u32x4*)(Ob + ro + bj * HALF) = w; } }
        }
    }
};
struct MoeSched { const LAS int* cnt; const LAS int* tbase; int G, vcu; };
__device__ __forceinline__ bool moe_next(const MoeSched& M, int i, int ncol, Unit& u) {
    const int L = i * M.G + M.vcu, total = M.tbase[NE] * ncol; if (L >= total) return false;
    const int ln = (int)threadIdx.x & 63, tb = M.tbase[ln < NE ? ln + 1 : NE];
    const int e = (int)__popcll(__ballot(ln < NE - 1 && L >= tb * ncol));
    const int tiles = M.tbase[e + 1] - M.tbase[e], loc = L - M.tbase[e] * ncol;
    u.e = e; u.pn = loc / tiles; u.pm = loc % tiles; u.rt = M.tbase[e] + u.pm;
    const int rem = M.cnt[e] - u.pm * BM; u.rows = rem < BM ? rem : BM; return true;
}
struct ProbGU {
    static constexpr bool PERM = true, GATHER = true;
    const fp8_t* U1; const fp8_t* WguT; const float* bgu; const int* list; fp8_t* ACT; MoeSched M;
    __device__ __forceinline__ bool next(int i, Unit& u) const { return moe_next(M, i, 8, u); }
    __device__ __forceinline__ void ids_prefetch(const Unit& u, LAS unsigned char* ids, int wave, int lane) const {
        if (wave < 4) __builtin_amdgcn_global_load_lds((const unsigned*)(list + (size_t)u.e * NTOK + u.pm * BM + 64 * wave + lane), (LAS unsigned*)(ids + wave * 256), 4, 0, 0); }
    __device__ __forceinline__ void ids_read(const Unit& u, const LAS unsigned char* ids, unsigned (&pk)[2]) const {
        int pR, pC; stage_rc((int)threadIdx.x * 16, pR, pC);
#pragma unroll
        for (int h = 0; h < 2; ++h) { const int r0 = h * HALF + pR, r1 = r0 + 64;
            const int p0 = *(const LAS int*)(ids + 4 * ((r0 < u.rows) ? r0 : 0)), p1 = *(const LAS int*)(ids + 4 * ((r1 < u.rows) ? r1 : 0));
            pk[h] = (unsigned)(p0 >> 2) | ((unsigned)(p1 >> 2) << 16); }
    }
    __device__ __forceinline__ void prefetch(const Unit& u, LAS unsigned char* pf, int wave, int lane) const {
        if (wave < 4) __builtin_amdgcn_global_load_lds((const unsigned*)(bgu + (size_t)u.e * DIN + u.pn * BM + 64 * wave + lane), (LAS unsigned*)(pf + wave * 256), 4, 0, 0); }
    __device__ __forceinline__ const char* a_base(const Unit&) const { return (const char*)U1; }
    __device__ __forceinline__ const char* b_base(const Unit& u) const { return (const char*)WguT + ((size_t)u.e * DIN + (size_t)u.pn * BM) * GK; }
    __device__ __forceinline__ void a_rows(const Unit& u, unsigned (&pk)[2]) const {
        const int* le = list + (size_t)u.e * NTOK + u.pm * BM;
        int pR, pC; stage_rc((int)threadIdx.x * 16, pR, pC);
#pragma unroll
        for (int h = 0; h < 2; ++h) { const int r0 = h * HALF + pR, r1 = r0 + 64;
            const int p0 = (r0 < u.rows) ? le[r0] : le[0], p1 = (r1 < u.rows) ? le[r1] : le[0];
            pk[h] = (unsigned)(p0 >> 2) | ((unsigned)(p1 >> 2) << 16); }
    }
    __device__ __forceinline__ void epi(const f32x4 (&acc)[2][2][4][2], const Unit& u, int wr, int wc, int fr, int fq, const LAS unsigned char* pf) const {
        int j0 = u.pn * HALF + wc * 32 + 8 * fq;
        int row0 = wr * 64 + fr;
        asm volatile("" : "+v"(row0), "+v"(j0));
        auto ACTb = launder(ACT);
        const LAS f32x4* bp = (const LAS f32x4*)(pf + (wc * 64 + 16 * fq) * 4);
        const f32x4 b0 = bp[0], b1 = bp[1], b2 = bp[2], b3 = bp[3];
        const float bg[8] = {b0[0], b0[2], b1[0], b1[2], b2[0], b2[2], b3[0], b3[2]};
        const float bl[8] = {b0[1], b0[3], b1[1], b1[3], b2[1], b2[3], b3[1], b3[3]};
#pragma unroll
        for (int ai = 0; ai < 2; ++ai)
#pragma unroll
            for (int m = 0; m < 4; ++m) {
                const int r = row0 + ai * HALF + m * 16;
                float o[8];
#pragma unroll
                for (int n = 0; n < 2; ++n)
#pragma unroll
                    for (int x = 0; x < 4; x += 2) {
                        f32x2 g = (f32x2){acc[ai][0][m][n][x], acc[ai][0][m][n][x + 1]} + (f32x2){bg[4 * n + x], bg[4 * n + x + 1]};
                        f32x2 l = (f32x2){acc[ai][1][m][n][x], acc[ai][1][m][n][x + 1]} + (f32x2){bl[4 * n + x], bl[4 * n + x + 1]};
                        g[0] = fminf(g[0], 7.0f); g[1] = fminf(g[1], 7.0f);
                        l[0] = __builtin_amdgcn_fmed3f(l[0], -7.0f, 7.0f); l[1] = __builtin_amdgcn_fmed3f(l[1], -7.0f, 7.0f);
                        const f32x2 t = g * (-1.702f * 1.4426950408889634f);
                        f32x2 d; d[0] = __builtin_amdgcn_exp2f(t[0]); d[1] = __builtin_amdgcn_exp2f(t[1]);
                        d = d + 1.0f;
                        f32x2 r; r[0] = __builtin_amdgcn_rcpf(d[0]); r[1] = __builtin_amdgcn_rcpf(d[1]);
                        const f32x2 res = (g * r) * (l * A8_SCALE + A8_SCALE);
                        o[4 * n + x] = res[0]; o[4 * n + x + 1] = res[1];
                    }
                u32x2 w; w.x = pk4_fp8(o[0], o[1], o[2], o[3]); w.y = pk4_fp8(o[4], o[5], o[6], o[7]);
                *(u32x2*)(ACTb + ((size_t)u.rt * BM + r) * D + j0) = w;
            }
    }
};
struct ProbDown {
    static constexpr bool PERM = true, GATHER = false;
    const fp8_t* ACT; const fp8_t* WdT; const float* bd; const int* list; const float* gatew; fp8_t* Y; MoeSched M;
    __device__ __forceinline__ bool next(int i, Unit& u) const { return moe_next(M, i, 4, u); }
    __device__ __forceinline__ void prefetch(const Unit& u, LAS unsigned char* pf, int wave, int lane) const {
        const size_t o = (size_t)u.e * NTOK + u.pm * BM + 64 * (wave & 3) + lane;
        const unsigned* src = (wave < 4) ? (const unsigned*)(list + o) : (const unsigned*)(gatew + o);
        __builtin_amdgcn_global_load_lds(src, (LAS unsigned*)(pf + wave * 256), 4, 0, 0);
        if (wave < 4) __builtin_amdgcn_global_load_lds((const unsigned*)(bd + (size_t)u.e * D + u.pn * BM + 64 * wave + lane), (LAS unsigned*)(pf + 2048 + wave * 256), 4, 0, 0); }
    __device__ __forceinline__ const char* a_base(const Unit& u) const { return (const char*)ACT + (size_t)u.rt * BM * GK; }
    __device__ __forceinline__ const char* b_base(const Unit& u) const { return (const char*)WdT + ((size_t)u.e * D + (size_t)u.pn * BM) * GK; }
    __device__ __forceinline__ void epi(const f32x4 (&acc)[2][2][4][2], const Unit& u, int wr, int wc, int fr, int fq, const LAS unsigned char* pf) const {
        int col0 = u.pn * BM + wc * 64 + 16 * fq, row0 = wr * 64 + fr;
        asm volatile("" : "+v"(row0), "+v"(col0));
        auto Yb = launder(Y);
        f32x4 bv[2][2];
#pragma unroll
        for (int bj = 0; bj < 2; ++bj)
#pragma unroll
            for (int n = 0; n < 2; ++n) bv[bj][n] = *(const LAS f32x4*)(pf + 2048 + (wc * 64 + 16 * fq + bj * 8 + 4 * n) * 4);
        int pr[8]; float gw[8];
#pragma unroll
        for (int k = 0; k < 8; ++k) { const int r = row0 + (k >> 2) * HALF + (k & 3) * 16; pr[k] = *(const LAS int*)(pf + 4 * r); gw[k] = *(const LAS float*)(pf + 1024 + 4 * r); }
#pragma unroll
        for (int ai = 0; ai < 2; ++ai)
#pragma unroll
            for (int m = 0; m < 4; ++m) {
                const int r = row0 + ai * HALF + m * 16, k = ai * 4 + m;
                u32x2 w[2];
#pragma unroll
                for (int bj = 0; bj < 2; ++bj) { const f32x4 v0 = (acc[ai][bj][m][0] + bv[bj][0]) * (gw[k] * Y8_SCALE), v1 = (acc[ai][bj][m][1] + bv[bj][1]) * (gw[k] * Y8_SCALE);
                    w[bj].x = pk4_fp8(v0[0], v0[1], v0[2], v0[3]); w[bj].y = pk4_fp8(v1[0], v1[1], v1[2], v1[3]); }
                if (r < u.rows) { u32x4 o; o.x = w[0].x; o.y = w[0].y; o.z = w[1].x; o.w = w[1].y; *(u32x4*)(Yb + (size_t)pr[k] * D + col0) = o; }
            }
    }
};

__device__ __forceinline__ float wave_dot_bf16(const bf16_t* a, const bf16_t* b, int lane) {
    const u32x4 a0 = *(const u32x4*)(a + 16 * lane), a1 = *(const u32x4*)(a + 16 * lane + 8);
    const u32x4 b0 = *(const u32x4*)(b + 16 * lane), b1 = *(const u32x4*)(b + 16 * lane + 8);
    float s = 0.f;
#pragma unroll
    for (int j = 0; j < 4; ++j) { s += bflo(a0[j]) * bflo(b0[j]) + bfhi(a0[j]) * bfhi(b0[j]); s += bflo(a1[j]) * bflo(b1[j]) + bfhi(a1[j]) * bfhi(b1[j]); }
    return wave_sum(s);
}

struct Frame {
    LAS unsigned char* lds;
    int tid, lane, wave, G, vcu, gw, NGW;
    const float* in[24]; float* out; unsigned char* ws;
    unsigned* ctl;
    bf16_t *WinT, *WoutT, *WaT, *WxT, *UMETA, *ZMETA, *U0, *Z, *MIX;
    fp8_t *WguT, *WdT, *U1, *ACT, *Y;
    float *WR, *HMETA, *SUMM, *GATEW; bf16_t* H1;
    int* LIST;
};

template <int MAP, bool FP8, bool NT = false>
__device__ __forceinline__ void p0_transpose_item(const float* W, int K, int N, void* WTv, LAS float* scr, int item, int lane) {
    const int nblk = N / 64, kb = item / nblk, nb = item % nblk, k0 = 64 * kb, n0 = 64 * nb;
    if (NT) {
        f32x4 v[16];
#pragma unroll
        for (int i = 0; i < 16; ++i) { const int kk = 4 * i + (lane >> 4); v[i] = __builtin_nontemporal_load((const f32x4*)(W + (size_t)(k0 + kk) * N + n0 + 4 * (lane & 15))); }
        __builtin_amdgcn_sched_barrier(0);
#pragma unroll
        for (int i = 0; i < 16; ++i) { const int kk = 4 * i + (lane >> 4); LAS float* s = scr + kk * 65 + 4 * (lane & 15); s[0] = v[i][0]; s[1] = v[i][1]; s[2] = v[i][2]; s[3] = v[i][3]; }
    } else {
#pragma unroll 4
    for (int i = 0; i < 16; ++i) { const int kk = 4 * i + (lane >> 4); const f32x4* wp = (const f32x4*)(W + (size_t)(k0 + kk) * N + n0 + 4 * (lane & 15)); const f32x4 v = *wp;
        LAS float* s = scr + kk * 65 + 4 * (lane & 15); s[0] = v[0]; s[1] = v[1]; s[2] = v[2]; s[3] = v[3]; }
    }
    asm volatile("s_waitcnt lgkmcnt(0)" ::: "memory");
    const int c = lane & 7;
#pragma unroll
    for (int j = 0; j < 8; ++j) { const int n = (lane >> 3) + 8 * j; const LAS float* s = scr + (8 * c) * 65 + n;
        const int ng = n0 + n; int row = ng;
        if (MAP == 1) { const int jj = ng >> 1, half = ng & 1; row = (jj >> 7) * 256 + half * 128 + (jj & 127); }
        if (MAP == 2) { const int m = ng & 255; row = (ng & ~255) + ((m >> 3) & 1) * 128 + (m >> 6) * 32 + ((m >> 4) & 3) * 8 + (m & 7); }
        if (MAP == 3) { const int m = ng & 255; row = (ng & ~255) + ((m >> 5) & 1) * 128 + (m >> 6) * 32 + (m & 31); }
        if (FP8) { u32x2 o; o.x = pk4_fp8(s[0 * 65] * W8_SCALE, s[1 * 65] * W8_SCALE, s[2 * 65] * W8_SCALE, s[3 * 65] * W8_SCALE); o.y = pk4_fp8(s[4 * 65] * W8_SCALE, s[5 * 65] * W8_SCALE, s[6 * 65] * W8_SCALE, s[7 * 65] * W8_SCALE);
            *(u32x2*)((fp8_t*)WTv + (size_t)row * K + k0 + 8 * c) = o; }
        else { u32x4 o; o.x = pk2(s[0 * 65], s[1 * 65]); o.y = pk2(s[2 * 65], s[3 * 65]); o.z = pk2(s[4 * 65], s[5 * 65]); o.w = pk2(s[6 * 65], s[7 * 65]);
            *(u32x4*)((bf16_t*)WTv + (size_t)row * K + k0 + 8 * c) = o; } }
    asm volatile("s_waitcnt lgkmcnt(0)" ::: "memory");
}
__device__ __forceinline__ void rms_row_to_bf16(const float* xrow, const float* g, bf16_t* orow, int lane) {
    f32x4 v[4]; float s = 0.f;
#pragma unroll
    for (int j = 0; j < 4; ++j) { v[j] = *(const f32x4*)(xrow + 4 * lane + 256 * j); s += (v[j][0] * v[j][0] + v[j][1] * v[j][1]) + (v[j][2] * v[j][2] + v[j][3] * v[j][3]); }
    const float rstd = 1.0f / sqrtf(wave_sum(s) * (1.0f / D) + NORM_EPS);
#pragma unroll
    for (int j = 0; j < 4; ++j) { const f32x4 gv = *(const f32x4*)(g + 4 * lane + 256 * j);
        u32x2 o; o.x = pk2(v[j][0] * rstd * gv[0], v[j][1] * rstd * gv[1]); o.y = pk2(v[j][2] * rstd * gv[2], v[j][3] * rstd * gv[3]);
        *(u32x2*)(orow + 4 * lane + 256 * j) = o; }
}
__device__ __forceinline__ void expert_weights_to_fp8(Frame& F, int vw, int nvw, int k_lo, int k_hi) {
    LAS float* scr = (LAS float*)(F.lds + 4096 + F.wave * 16640);
    constexpr int I_GU = NE * (D / 64) * (DIN / 64), I_D = NE * (D / 64) * (D / 64);
    for (int k = k_lo; k < k_hi; ++k) {
        int r = k * nvw + vw; if (r >= I_D + I_GU) break;
        if (r < I_D) { const int e = r / (I_D / NE), q = r % (I_D / NE); p0_transpose_item<2, true, true>(F.in[I_WD] + (size_t)e * D * D, D, D, F.WdT + (size_t)e * D * D, scr, q, F.lane); continue; } r -= I_D;
        { const int e = r / (I_GU / NE), q = r % (I_GU / NE); p0_transpose_item<1, true, true>(F.in[I_WGU] + (size_t)e * D * DIN, D, DIN, F.WguT + (size_t)e * DIN * D, scr, q, F.lane); }
    }
}
__device__ __forceinline__ void p0_prologue(Frame& F) {
    LAS float* scr = (LAS float*)(F.lds + F.wave * 16640);
    constexpr int I_IN = (D / 64) * (DIN / 64), I_OUT = (D / 64) * (D / 64), I_G = 2 * NH;
    constexpr int NITEMS = I_IN + I_OUT + I_G;
    for (int it = F.gw; it < NITEMS; it += F.NGW) {
        int r = it;
        if (r < I_IN) { p0_transpose_item<3, false>(F.in[I_WIN], D, DIN, F.WinT, scr, r, F.lane); continue; } r -= I_IN;
        if (r < I_OUT) { p0_transpose_item<0, false>(F.in[I_WOUT], D, D, F.WoutT, scr, r, F.lane); continue; } r -= I_OUT;
        { const int h = r >> 1; if (r & 1) p0_transpose_item<0, false>(F.in[I_WX] + h * HD * HD, HD, HD, F.WxT + h * HD * HD, scr, 0, F.lane);
          else p0_transpose_item<0, false>(F.in[I_WA] + h * HD * HD, HD, HD, F.WaT + h * HD * HD, scr, 0, F.lane); }
    }
    {
        f32x4 gv[4];
#pragma unroll
        for (int j = 0; j < 4; ++j) gv[j] = *(const f32x4*)(F.in[I_GMIX] + 4 * F.lane + 256 * j);
#pragma unroll 1
        for (int m0 = F.gw; m0 < NTOK + NMETA; m0 += 4 * F.NGW) {
            f32x4 v[4][4]; float ss[4];
#pragma unroll
            for (int i = 0; i < 4; ++i) { int m = m0 + i * F.NGW; m = m < NTOK + NMETA ? m : m0;
                const float* xr = (m < NTOK) ? F.in[I_X] + (size_t)m * D : F.in[I_META] + (size_t)(m - NTOK) * D;
#pragma unroll
                for (int j = 0; j < 4; ++j) v[i][j] = *(const f32x4*)(xr + 4 * F.lane + 256 * j); }
            __builtin_amdgcn_sched_barrier(0);
#pragma unroll
            for (int i = 0; i < 4; ++i) { float sq = 0.f;
#pragma unroll
                for (int j = 0; j < 4; ++j) sq += (v[i][j][0] * v[i][j][0] + v[i][j][1] * v[i][j][1]) + (v[i][j][2] * v[i][j][2] + v[i][j][3] * v[i][j][3]);
                ss[i] = sq; }
#pragma unroll
            for (int i = 0; i < 4; ++i) ss[i] = wave_sum(ss[i]);
#pragma unroll
            for (int i = 0; i < 4; ++i) { const int m = m0 + i * F.NGW;
                if (m < NTOK + NMETA) { const float rstd = 1.0f / sqrtf(ss[i] * (1.0f / D) + NORM_EPS);
                    bf16_t* orow = (m < NTOK) ? F.U0 + (size_t)m * D : F.UMETA + (size_t)(m - NTOK) * D;
#pragma unroll
                    for (int j = 0; j < 4; ++j) { u32x2 o; o.x = pk2(v[i][j][0] * rstd * gv[j][0], v[i][j][1] * rstd * gv[j][1]); o.y = pk2(v[i][j][2] * rstd * gv[j][2], v[i][j][3] * rstd * gv[j][3]);
                        *(u32x2*)(orow + 4 * F.lane + 256 * j) = o; } } }
        }
    }
    for (int i = blockIdx.x * NTHREADS + F.tid; i < D * NE; i += F.G * NTHREADS) { const int k = i >> 5, e = i & 31; const float w = F.in[I_GFFN][k] * F.in[I_WROUTER][i];
        const unsigned hi = f2bf(w), lo = f2bf(w - bf2f(hi)); bf16_t* wr = (bf16_t*)F.WR; wr[e * D + k] = (bf16_t)hi; wr[NE * D + e * D + k] = (bf16_t)lo; }
}

__device__ __forceinline__ void p1_zmeta(Frame& F) {
    LAS float* part = (LAS float*)F.lds;
    const int lane = F.lane, q = lane >> 4, c16 = lane & 15;
    for (int ct = F.vcu; ct < DIN / 16; ct += F.G) {
        const bf16_t* arow = F.UMETA + (size_t)c16 * D + F.wave * 128 + 8 * q;
        const bf16_t* brow = F.WinT + (size_t)(ct * 16 + c16) * D + F.wave * 128 + 8 * q;
        bf16x8 af[4], bf[4];
#pragma unroll
        for (int s = 0; s < 4; ++s) { af[s] = *(const bf16x8*)(arow + 32 * s); bf[s] = *(const bf16x8*)(brow + 32 * s); }
        __builtin_amdgcn_sched_barrier(0);
        f32x4 acc = (f32x4){0.f, 0.f, 0.f, 0.f};
#pragma unroll
        for (int s = 0; s < 4; ++s) acc = __builtin_amdgcn_mfma_f32_16x16x32_bf16(af[s], bf[s], acc, 0, 0, 0);
        __syncthreads();
#pragma unroll
        for (int r = 0; r < 4; ++r) part[(F.wave * 16 + 4 * q + r) * 16 + c16] = acc[r];
        __syncthreads();
        if (F.tid < 256) { float t = 0.f;
#pragma unroll
            for (int w = 0; w < 8; ++w) t += part[w * 256 + F.tid];
            const int sl = ct * 16 + (F.tid & 15), m = sl & 255, col = (sl & ~255) + ((m >> 5) & 3) * 64 + (m >> 7) * 32 + (m & 31);
            const bf16_t zv = (bf16_t)f2bf(t);
#pragma unroll
            for (int bb = 0; bb < NB; ++bb) { F.Z[((size_t)bb * ZB + NMETA + (F.tid >> 4)) * DIN + col] = zv; F.Z[((size_t)bb * ZB + (F.tid >> 4)) * DIN + col] = (bf16_t)0; } }
    }
    __syncthreads();
}

__device__ __forceinline__ unsigned zrow_off(int b, int tp, float& valid) {
    valid = 1.0f;
    return (unsigned)WS_Z + (unsigned)(b * ZB + ZPAD + tp) * (unsigned)(DIN * 2);
}
__device__ __forceinline__ void conformer_tile(Frame& F, int b, int t0) {
    LAS bf16_t* co = (LAS bf16_t*)F.lds;
    LAS float* wl = (LAS float*)(F.lds + 65536);
    const GAS unsigned char* wsg = (const GAS unsigned char*)F.ws;
    const int cp = F.tid & 255, half = F.tid >> 8, c0 = 2 * cp;
    auto cdw = launder(F.in[I_CDW]); auto cdb = launder(F.in[I_CDB]);
    auto lng = launder(F.in[I_CLNG]); auto lnb = launder(F.in[I_CLNB]);
    const f32x4 lg0 = *(const f32x4*)(lng + 8 * F.lane), lg1 = *(const f32x4*)(lng + 8 * F.lane + 4);
    const f32x4 lb0 = *(const f32x4*)(lnb + 8 * F.lane), lb1 = *(const f32x4*)(lnb + 8 * F.lane + 4);
    { f32x4 tw[8];
#pragma unroll
      for (int i = 0; i < 8; ++i) { const int idx = F.tid + i * NTHREADS; tw[i] = *(const f32x4*)(cdw + 4 * (idx < CK * CW / 4 ? idx : 0)); }
#pragma unroll
      for (int i = 0; i < 8; ++i) { const int idx = F.tid + i * NTHREADS; if (idx < CK * CW / 4) *(LAS f32x4*)(wl + 4 * idx) = tw[i]; } }
    const f32x2 cb = *(const f32x2*)(cdb + c0);
    float g0[38], g1[38];
    const int tb = t0 + 32 * half;
    auto row_ld = [&](int tp, unsigned& v, unsigned& g, float& ok) { const unsigned zo = zrow_off(b, tp, ok); v = *(const GAS unsigned*)(wsg + zo + 2 * c0); g = *(const GAS unsigned*)(wsg + zo + 2 * (CW + c0)); };
    auto glu = [&](unsigned v, unsigned g, float ok, float& o0, float& o1) { o0 = ok * bflo(v) * sigmoidf_(bflo(g)); o1 = ok * bfhi(v) * sigmoidf_(bfhi(g)); };
#pragma unroll
    for (int i0 = 0; i0 < 30; i0 += 15) {
        unsigned rv[15], rg[15]; float rk[15];
#pragma unroll
        for (int i = 0; i < 15; ++i) row_ld(tb - 30 + i0 + i, rv[i], rg[i], rk[i]);
        __builtin_amdgcn_sched_barrier(0);
#pragma unroll
        for (int i = 0; i < 15; ++i) glu(rv[i], rg[i], rk[i], g0[i0 + i], g1[i0 + i]);
    }
    unsigned nv[8], ng[8]; float nk[8];
#pragma unroll
    for (int i = 0; i < 8; ++i) row_ld(tb + i, nv[i], ng[i], nk[i]);
    __syncthreads();
#pragma unroll 1
    for (int run = 0; run < 4; ++run) {
        const int ts = tb + 8 * run;
#pragma unroll
        for (int i = 0; i < 8; ++i) glu(nv[i], ng[i], nk[i], g0[30 + i], g1[30 + i]);
        if (run < 3) {
#pragma unroll
            for (int i = 0; i < 8; ++i) row_ld(ts + 8 + i, nv[i], ng[i], nk[i]); }
        __builtin_amdgcn_sched_barrier(0);
        float a0[8], a1[8];
#pragma unroll
        for (int o = 0; o < 8; ++o) { a0[o] = cb[0]; a1[o] = cb[1]; }
#pragma unroll
        for (int k = 0; k < CK; ++k) { const f32x2 w = *(const LAS f32x2*)(wl + k * CW + c0);
#pragma unroll
            for (int o = 0; o < 8; ++o) { a0[o] += w[0] * g0[o + k]; a1[o] += w[1] * g1[o + k]; } }
#pragma unroll
        for (int o = 0; o < 8; ++o) *(LAS unsigned*)(co + (ts - t0 + o) * CW + c0) = pk2(a0[o], a1[o]);
#pragma unroll
        for (int i = 0; i < 30; ++i) { g0[i] = g0[i + 8]; g1[i] = g1[i + 8]; }
    }
    __syncthreads();
#pragma unroll 1
    for (int i0 = 0; i0 < 8; i0 += 4) {
        f32x4 v0[4], v1[4]; float mean[4], var[4];
#pragma unroll
        for (int i = 0; i < 4; ++i) { const int tl = F.wave * 8 + i0 + i; const u32x4 cv = *(const LAS u32x4*)(co + tl * CW + 8 * F.lane);
            v0[i] = (f32x4){bflo(cv[0]), bfhi(cv[0]), bflo(cv[1]), bfhi(cv[1])}; v1[i] = (f32x4){bflo(cv[2]), bfhi(cv[2]), bflo(cv[3]), bfhi(cv[3])};
            mean[i] = (v0[i][0] + v0[i][1]) + (v0[i][2] + v0[i][3]) + (v1[i][0] + v1[i][1]) + (v1[i][2] + v1[i][3]); }
#pragma unroll
        for (int i = 0; i < 4; ++i) mean[i] = wave_sum(mean[i]);
#pragma unroll
        for (int i = 0; i < 4; ++i) { mean[i] *= (1.0f / CW); v0[i] = v0[i] - mean[i]; v1[i] = v1[i] - mean[i];
            var[i] = (v0[i][0] * v0[i][0] + v0[i][1] * v0[i][1]) + (v0[i][2] * v0[i][2] + v0[i][3] * v0[i][3]) + (v1[i][0] * v1[i][0] + v1[i][1] * v1[i][1]) + (v1[i][2] * v1[i][2] + v1[i][3] * v1[i][3]); }
#pragma unroll
        for (int i = 0; i < 4; ++i) var[i] = wave_sum(var[i]);
#pragma unroll
        for (int i = 0; i < 4; ++i) { const int tl = F.wave * 8 + i0 + i; const float rstd = __builtin_amdgcn_rsqf(var[i] * (1.0f / CW) + LN_EPS);
            float y[8];
#pragma unroll
            for (int j = 0; j < 4; ++j) { y[j] = v0[i][j] * rstd * lg0[j] + lb0[j]; y[4 + j] = v1[i][j] * rstd * lg1[j] + lb1[j]; }
#pragma unroll
            for (int j = 0; j < 8; ++j) y[j] = y[j] * sigmoidf_(y[j]);
            u32x4 o; o.x = pk2(y[0], y[1]); o.y = pk2(y[2], y[3]); o.z = pk2(y[4], y[5]); o.w = pk2(y[6], y[7]);
            *(u32x4*)(F.MIX + ((size_t)b * SEQ + t0 + tl) * D + 8 * F.lane) = o; }
    }
    __syncthreads();
}
constexpr int XC_STRIDE = 520;
constexpr int LDS_XC = 0, LDS_AB = 64 * XC_STRIDE * 2, LDS_CARRY = LDS_AB + NWAVES * 8192;
template <bool FINAL>
__device__ __forceinline__ void lru_tile(Frame& F, int b_, int t0_, int first_valid_, int start_tp_, float* sa_, float* sh_, bool with_meta = false) {
    LAS bf16_t* xc = (LAS bf16_t*)(F.lds + LDS_XC);
    const GAS unsigned char* wsg = (const GAS unsigned char*)F.ws;
    const int h = F.wave, lane = F.lane, q = lane >> 4, c16 = lane & 15;
    LAS f32x2* ab = (LAS f32x2*)(F.lds + LDS_AB + h * 8192);
    bf16x8 Ba[4][2], Bx[4][2];
    auto wat = launder(F.WaT); auto wxt = launder(F.WxT);
#pragma unroll
    for (int n = 0; n < 4; ++n)
#pragma unroll
        for (int ks = 0; ks < 2; ++ks) {
            Ba[n][ks] = *(const GAS bf16x8*)(wat + ((size_t)h * HD + n * 16 + c16) * HD + ks * 32 + 8 * q);
            Bx[n][ks] = *(const GAS bf16x8*)(wxt + ((size_t)h * HD + n * 16 + c16) * HD + ks * 32 + 8 * q);
        }
    float bav[4], bxv[4], lamv[4];
    auto pba = launder(F.in[I_BA]); auto pbx = launder(F.in[I_BX]); auto plam = launder(F.in[I_LAM]);
#pragma unroll
    for (int n = 0; n < 4; ++n) { const int ch = h * HD + n * 16 + c16; bav[n] = pba[ch]; bxv[n] = pbx[ch]; lamv[n] = plam[ch]; }
#pragma unroll 1
    for (int pass = with_meta ? 0 : 1; pass < 2; ++pass) {
    const bool mp = (pass == 0);
    const int b = mp ? 0 : b_, t0 = mp ? -TT : t0_, first_valid = mp ? -NMETA : first_valid_, start_tp = mp ? -NMETA : start_tp_;
    float* sa = mp ? F.HMETA + LW : sa_; float* sh = mp ? F.HMETA : sh_;
    {
        const int cp = F.tid & 255, half = F.tid >> 8, c0 = 2 * cp;
        float w0[4], w1[4];
#pragma unroll
        for (int k = 0; k < 4; ++k) { const f32x2 w = *(const f32x2*)(launder(F.in[I_LCW]) + k * LW + c0); w0[k] = w[0]; w1[k] = w[1]; }
        const f32x2 cb = *(const f32x2*)(launder(F.in[I_LCB]) + c0);
        const int tb = t0 + 32 * half;
        int o0 = first_valid - tb; o0 = o0 < 0 ? 0 : (o0 > 32 ? 32 : o0); o0 &= ~15;
        float x0[3], x1[3];
        auto rx_ld = [&](int tp, unsigned& v, float& ok) { const unsigned zo = zrow_off(b, tp, ok); v = *(const GAS unsigned*)(wsg + zo + 2 * (2 * CW + c0)); };
        if (o0 < 32) {
            { unsigned hv[3]; float hk[3];
#pragma unroll
              for (int i = 0; i < 3; ++i) rx_ld(tb + o0 - 3 + i, hv[i], hk[i]);
#pragma unroll
              for (int i = 0; i < 3; ++i) { x0[i] = hk[i] * bflo(hv[i]); x1[i] = hk[i] * bfhi(hv[i]); } }
#pragma unroll 1
            for (int ob = o0; ob < 32; ob += 16) {
                unsigned rv[16]; float rk[16];
#pragma unroll
                for (int i = 0; i < 16; ++i) rx_ld(tb + ob + i, rv[i], rk[i]);
                __builtin_amdgcn_sched_barrier(0);
#pragma unroll
                for (int i = 0; i < 16; ++i) {
                    const float n0 = rk[i] * bflo(rv[i]), n1 = rk[i] * bfhi(rv[i]);
                    const float a0 = cb[0] + w0[0] * x0[0] + w0[1] * x0[1] + w0[2] * x0[2] + w0[3] * n0;
                    const float a1 = cb[1] + w1[0] * x1[0] + w1[1] * x1[1] + w1[2] * x1[2] + w1[3] * n1;
                    *(LAS unsigned*)(xc + (32 * half + ob + i) * XC_STRIDE + c0) = pk2(a0, a1);
                    x0[0] = x0[1]; x0[1] = x0[2]; x0[2] = n0; x1[0] = x1[1]; x1[1] = x1[2]; x1[2] = n1;
                }
            }
        }
    }
    __syncthreads();
    float spv[4];
#pragma unroll
    for (int n = 0; n < 4; ++n) { const float nl = -lamv[n]; spv[n] = fmaxf(nl, 0.f) + log1pf(__expf(-fabsf(nl))); }
    const int chl = h * HD + lane;
    float hs = FINAL ? ((const LAS float*)(F.lds + LDS_CARRY))[chl] : 0.f, aprod = 1.f;
    for (int mt = 0; mt < 4; ++mt) {
        if (t0 + mt * 16 + 15 < first_valid) continue;
        f32x4 accR[4], accI[4];
#pragma unroll
        for (int n = 0; n < 4; ++n) { accR[n] = (f32x4){0.f, 0.f, 0.f, 0.f}; accI[n] = (f32x4){0.f, 0.f, 0.f, 0.f}; }
#pragma unroll
        for (int ks = 0; ks < 2; ++ks) {
            const bf16x8 A = *(const LAS bf16x8*)(xc + (mt * 16 + c16) * XC_STRIDE + h * HD + ks * 32 + 8 * q);
#pragma unroll
            for (int n = 0; n < 4; ++n) { accR[n] = __builtin_amdgcn_mfma_f32_16x16x32_bf16(A, Ba[n][ks], accR[n], 0, 0, 0); accI[n] = __builtin_amdgcn_mfma_f32_16x16x32_bf16(A, Bx[n][ks], accI[n], 0, 0, 0); }
        }
#pragma unroll
        for (int n = 0; n < 4; ++n)
#pragma unroll
            for (int r = 0; r < 4; ++r) {
                const int tl = mt * 16 + 4 * q + r;
                const float rg = sigmoidf_(accR[n][r] + bav[n]), ig = sigmoidf_(accI[n][r] + bxv[n]);
                const float la = -8.0f * rg * spv[n];
                const float a = __expf(la);
                const float om = fmaxf(fmaf(-a, a, 1.0f), 0.0f);
                float mult = __builtin_amdgcn_sqrtf(om);
                if (t0 + tl == start_tp) mult = 1.0f;
                const float xv = bf2f(xc[tl * XC_STRIDE + h * HD + n * 16 + c16]);
                ab[(4 * q + r) * 64 + n * 16 + c16] = (f32x2){a, mult * ig * xv};
            }
        float gv[16];
        if (FINAL) {
#pragma unroll
            for (int i = 0; i < 16; ++i) gv[i] = bf2f(F.Z[((size_t)b * ZB + ZPAD + t0 + mt * 16 + i) * DIN + 3 * CW + chl]);
        }
        asm volatile("s_waitcnt lgkmcnt(0)" ::: "memory");
#pragma unroll
        for (int i = 0; i < 16; ++i) {
            const f32x2 v = ab[i * 64 + lane];
            if (t0 + mt * 16 + i >= first_valid) { hs = v[0] * hs + v[1]; aprod *= v[0]; }
            if (!FINAL && t0 >= 0) ((unsigned*)(F.ws + WS_AB))[((size_t)b * SEQ + t0 + mt * 16 + i) * LW + chl] = pk2(1.0f - v[0], v[1]);
            if (FINAL) F.MIX[((size_t)b * SEQ + t0 + mt * 16 + i) * D + CW + chl] = (bf16_t)f2bf(hs * gelu_tanh(gv[i]));
        }
        asm volatile("s_waitcnt lgkmcnt(0)" ::: "memory");
    }
    if (!FINAL) { sa[chl] = aprod; sh[chl] = hs; }
    __syncthreads();
    }
}

__device__ __forceinline__ void p5_route_tile(Frame& F, int r0) {
    LAS float* atile = (LAS float*)(F.lds + F.wave * 4352);
    LAS float* plog = (LAS float*)(F.lds + 36864);
    LAS float* rstd_s = (LAS float*)(F.lds + 36864 + 16384);
    LAS int* sel_e = (LAS int*)(F.lds + 36864 + 16384 + 256);
    LAS float* sel_w = (LAS float*)(F.lds + 36864 + 16384 + 256 + 1024);
    LAS int* rank_s = (LAS int*)(F.lds + 36864 + 16384 + 256 + 2048);
    LAS int* lhist = (LAS int*)(F.lds + 36864 + 16384 + 256 + 3072);
    LAS int* lbase = (LAS int*)(F.lds + 36864 + 16384 + 256 + 3072 + 128);
    LAS float* brs = (LAS float*)(F.lds + 36864 + 16384 + 256 + 3072 + 256);
    if (F.tid < NE) { lhist[F.tid] = 0; brs[F.tid] = F.in[I_BROUTER][F.tid]; }
    {
        f32x4 gv[4];
#pragma unroll
        for (int j = 0; j < 4; ++j) gv[j] = *(const f32x4*)(F.in[I_GFFN] + 4 * F.lane + 256 * j);
#pragma unroll 1
        for (int hb = 0; hb < 2; ++hb) {
            f32x4 v[4][4]; float ss[4]; u32x2 hraw[4][4];
#pragma unroll
            for (int i = 0; i < 4; ++i)
#pragma unroll
                for (int j = 0; j < 4; ++j) hraw[i][j] = *(const u32x2*)(F.H1 + (size_t)(r0 + F.wave * 8 + hb * 4 + i) * D + 4 * F.lane + 256 * j);
            __builtin_amdgcn_sched_barrier(0);
#pragma unroll
            for (int i = 0; i < 4; ++i)
#pragma unroll
                for (int j = 0; j < 4; ++j) v[i][j] = (f32x4){bflo(hraw[i][j].x), bfhi(hraw[i][j].x), bflo(hraw[i][j].y), bfhi(hraw[i][j].y)};
#pragma unroll
            for (int i = 0; i < 4; ++i) { float s = 0.f;
#pragma unroll
                for (int j = 0; j < 4; ++j) s += (v[i][j][0] * v[i][j][0] + v[i][j][1] * v[i][j][1]) + (v[i][j][2] * v[i][j][2] + v[i][j][3] * v[i][j][3]);
                ss[i] = s; }
#pragma unroll
            for (int i = 0; i < 4; ++i) ss[i] = wave_sum(ss[i]);
#pragma unroll
            for (int i = 0; i < 4; ++i) { const int rl = F.wave * 8 + hb * 4 + i; const float rstd = 1.0f / sqrtf(ss[i] * (1.0f / D) + NORM_EPS);
                if (F.lane == 0) rstd_s[rl] = rstd;
                const float sc = rstd * A8_SCALE;
#pragma unroll
                for (int j = 0; j < 4; ++j) *(unsigned*)(F.U1 + (size_t)(r0 + rl) * D + 4 * F.lane + 256 * j) = pk4_fp8(v[i][j][0] * sc * gv[j][0], v[i][j][1] * sc * gv[j][1], v[i][j][2] * sc * gv[j][2], v[i][j][3] * sc * gv[j][3]); }
        }
    }
    {
        const int mt = F.wave & 3, kh = F.wave >> 2, lane = F.lane, q = lane >> 4, c16 = lane & 15;
        f32x4 acc0 = (f32x4){0.f, 0.f, 0.f, 0.f}, acc1 = (f32x4){0.f, 0.f, 0.f, 0.f};
        const bf16_t* arow = F.H1 + (size_t)(r0 + mt * 16 + c16) * D + kh * 512 + 8 * q;
        const bf16_t* wr = (const bf16_t*)F.WR + (size_t)c16 * D + kh * 512 + 8 * q;
#pragma unroll 1
        for (int s0 = 0; s0 < 16; s0 += 4) {
            bf16x8 af[4], bh0[4], bh1[4], bl0[4], bl1[4];
#pragma unroll
            for (int s = 0; s < 4; ++s) { const int ko = 32 * (s0 + s);
                af[s] = *(const bf16x8*)(arow + ko);
                bh0[s] = *(const bf16x8*)(wr + ko); bh1[s] = *(const bf16x8*)(wr + 16 * D + ko);
                bl0[s] = *(const bf16x8*)(wr + NE * D + ko); bl1[s] = *(const bf16x8*)(wr + NE * D + 16 * D + ko); }
            __builtin_amdgcn_sched_barrier(0);
#pragma unroll
            for (int s = 0; s < 4; ++s) {
                acc0 = __builtin_amdgcn_mfma_f32_16x16x32_bf16(af[s], bh0[s], acc0, 0, 0, 0); acc0 = __builtin_amdgcn_mfma_f32_16x16x32_bf16(af[s], bl0[s], acc0, 0, 0, 0);
                acc1 = __builtin_amdgcn_mfma_f32_16x16x32_bf16(af[s], bh1[s], acc1, 0, 0, 0); acc1 = __builtin_amdgcn_mfma_f32_16x16x32_bf16(af[s], bl1[s], acc1, 0, 0, 0);
            }
        }
#pragma unroll
        for (int r = 0; r < 4; ++r) { plog[(kh * 64 + mt * 16 + 4 * q + r) * NE + c16] = acc0[r]; plog[(kh * 64 + mt * 16 + 4 * q + r) * NE + 16 + c16] = acc1[r]; }
    }
    __syncthreads();
    if (F.tid < 64) {
        const int t = F.tid; const float rs = rstd_s[t];
        float b0 = -3.0e38f, b1 = -3.0e38f, b2 = -3.0e38f, b3 = -3.0e38f; int i0 = 0, i1 = 0, i2 = 0, i3 = 0;
#pragma unroll 1
        for (int e4 = 0; e4 < NE; e4 += 4) {
            const f32x4 pa = *(const LAS f32x4*)(plog + t * NE + e4), pb = *(const LAS f32x4*)(plog + (64 + t) * NE + e4), bb = *(const LAS f32x4*)(brs + e4);
#pragma unroll
            for (int u = 0; u < 4; ++u) { const int e = e4 + u;
                const float v = (pa[u] + pb[u]) * rs + bb[u];
                if (v > b3) {
                    if (v > b2) { b3 = b2; i3 = i2;
                        if (v > b1) { b2 = b1; i2 = i1;
                            if (v > b0) { b1 = b0; i1 = i0; b0 = v; i0 = e; } else { b1 = v; i1 = e; }
                        } else { b2 = v; i2 = e; }
                    } else { b3 = v; i3 = e; }
                }
            }
        }
        const float e0 = 1.0f, e1 = __expf(b1 - b0), e2 = __expf(b2 - b0), e3 = __expf(b3 - b0);
        const float inv = 1.0f / (e0 + e1 + e2 + e3);
        sel_e[t * 4 + 0] = i0; sel_e[t * 4 + 1] = i1; sel_e[t * 4 + 2] = i2; sel_e[t * 4 + 3] = i3;
        sel_w[t * 4 + 0] = e0 * inv; sel_w[t * 4 + 1] = e1 * inv; sel_w[t * 4 + 2] = e2 * inv; sel_w[t * 4 + 3] = e3 * inv;
    }
    __syncthreads();
    LAS int* wcnt = rank_s;
    int se = 0, rk = 0;
    if (F.tid < 256) {
        se = sel_e[F.tid]; unsigned long long mine = 0ull; int cnt_e = 0;
        for (int e = 0; e < NE; ++e) { const unsigned long long m = __ballot(se == e); if (se == e) mine = m; if (F.lane == e) cnt_e = __popcll(m); }
        rk = __popcll(mine & ((1ull << F.lane) - 1ull));
        if (F.lane < NE) wcnt[F.wave * NE + F.lane] = cnt_e;
    }
    __syncthreads();
    if (F.tid < 256) { for (int w = 0; w < F.wave; ++w) rk += wcnt[w * NE + se];
        const int pair = r0 * 4 + F.tid;
        __hip_atomic_store((int*)(F.ws + WS_PINFO) + pair, se | (rk << 8), __ATOMIC_RELAXED, __HIP_MEMORY_SCOPE_AGENT);
        __hip_atomic_store(F.GATEW + pair, sel_w[F.tid], __ATOMIC_RELAXED, __HIP_MEMORY_SCOPE_AGENT); }
    if (F.tid < NE) __hip_atomic_store((int*)(F.ws + WS_HIST) + (r0 / 64) * NE + F.tid, wcnt[F.tid] + wcnt[NE + F.tid] + wcnt[2 * NE + F.tid] + wcnt[3 * NE + F.tid], __ATOMIC_RELAXED, __HIP_MEMORY_SCOPE_AGENT);
    __syncthreads();
}

__device__ __forceinline__ void p5b_lists(Frame& F, int first, int stride) {
    LAS int* part = (LAS int*)F.lds;
    const int* hist = (const int*)(F.ws + WS_HIST); const int* pinfo = (const int*)(F.ws + WS_PINFO);
    for (int blk = first; blk < NTOK / 64; blk += stride) {
        { const int e = F.tid & 31, pt = F.tid >> 5; int sum = 0;
#pragma unroll
          for (int i = 0; i < 16; ++i) { const int b = pt + 16 * i; const int v = hist[b * NE + e]; sum += (b < blk) ? v : 0; }
          part[pt * NE + e] = sum; }
        __syncthreads();
        if (F.tid < NE) { int sum = 0; for (int pt = 0; pt < 16; ++pt) sum += part[pt * NE + F.tid]; part[512 + F.tid] = sum; }
        __syncthreads();
        if (F.tid < 256) { const int pair = blk * 256 + F.tid, info = pinfo[pair], e = info & 255, rk = info >> 8; const size_t pos = (size_t)e * NTOK + part[512 + e] + rk; F.LIST[pos] = pair; ((float*)(F.ws + WS_LISTG))[pos] = F.GATEW[pair]; }
        __syncthreads();
    }
}

__device__ __forceinline__ MoeSched moe_sched_build(Frame& F) {
    LAS int* cnt = (LAS int*)(F.lds + LDS_TAB); LAS int* tbase = cnt + 64;
    __syncthreads();
    { LAS int* part = cnt + 128; const int* hist = (const int*)(F.ws + WS_HIST); const int e = F.tid & 31, pt = F.tid >> 5; int sum = 0;
#pragma unroll
      for (int i = 0; i < 16; ++i) sum += hist[(pt + 16 * i) * NE + e];
      part[pt * NE + e] = sum; }
    __syncthreads();
    if (F.tid < NE) { int sum = 0; for (int pt = 0; pt < 16; ++pt) sum += cnt[128 + pt * NE + F.tid]; cnt[F.tid] = sum; }
    __syncthreads();
    if (F.tid == 0) { int s = 0; for (int e = 0; e < NE; ++e) { tbase[e] = s; s += (cnt[e] + BM - 1) / BM; } tbase[NE] = s; }
    __syncthreads();
    MoeSched M; M.cnt = cnt; M.tbase = tbase; M.G = F.G; M.vcu = F.vcu; return M;
}

__device__ __forceinline__ void p8_final(Frame& F) {
    f32x4 g0[2], g1[2];
#pragma unroll
    for (int hf = 0; hf < 2; ++hf) { const int k0 = hf * 512 + 8 * F.lane; g0[hf] = *(const f32x4*)(F.in[I_GFINAL] + k0); g1[hf] = *(const f32x4*)(F.in[I_GFINAL] + k0 + 4); }
#pragma unroll 1
    for (int m0 = F.gw; m0 < NTOK; m0 += 2 * F.NGW) {
        f32x4 ha[2][2], hb[2][2]; u32x2 yy[2][2][TOPK];
#pragma unroll
        for (int rr = 0; rr < 2; ++rr) { size_t m = (size_t)m0 + (size_t)rr * F.NGW; m = m < (size_t)NTOK ? m : (size_t)m0;
#pragma unroll
            for (int hf = 0; hf < 2; ++hf) { const int k0 = hf * 512 + 8 * F.lane;
                { const u32x4 hv = *(const u32x4*)(F.H1 + m * D + k0); ha[rr][hf] = (f32x4){bflo(hv[0]), bfhi(hv[0]), bflo(hv[1]), bfhi(hv[1])}; hb[rr][hf] = (f32x4){bflo(hv[2]), bfhi(hv[2]), bflo(hv[3]), bfhi(hv[3])}; }
#pragma unroll
                for (int k = 0; k < TOPK; ++k) yy[rr][hf][k] = *(const u32x2*)(F.Y + (m * TOPK + k) * D + k0); } }
        __builtin_amdgcn_sched_barrier(0);
#pragma unroll
        for (int rr = 0; rr < 2; ++rr) { const size_t m = (size_t)m0 + (size_t)rr * F.NGW; if (m >= (size_t)NTOK) continue;
            float v[16];
#pragma unroll
            for (int hf = 0; hf < 2; ++hf) {
                float acc8[8] = {0.f, 0.f, 0.f, 0.f, 0.f, 0.f, 0.f, 0.f};
#pragma unroll
                for (int k = 0; k < TOPK; ++k) {
                    const f32x2 p0 = __builtin_amdgcn_cvt_pk_f32_fp8((int)yy[rr][hf][k].x, false), p1 = __builtin_amdgcn_cvt_pk_f32_fp8((int)yy[rr][hf][k].x, true);
                    const f32x2 p2 = __builtin_amdgcn_cvt_pk_f32_fp8((int)yy[rr][hf][k].y, false), p3 = __builtin_amdgcn_cvt_pk_f32_fp8((int)yy[rr][hf][k].y, true);
                    acc8[0] += p0[0]; acc8[1] += p0[1]; acc8[2] += p1[0]; acc8[3] += p1[1]; acc8[4] += p2[0]; acc8[5] += p2[1]; acc8[6] += p3[0]; acc8[7] += p3[1]; }
#pragma unroll
                for (int j = 0; j < 4; ++j) { v[hf * 8 + j] = ha[rr][hf][j] + acc8[j] * (1.0f / Y8_SCALE); v[hf * 8 + 4 + j] = hb[rr][hf][j] + acc8[4 + j] * (1.0f / Y8_SCALE); }
            }
            float s = 0.f;
#pragma unroll
            for (int j = 0; j < 16; ++j) s += v[j] * v[j];
            const float rstd = 1.0f / sqrtf(wave_sum(s) * (1.0f / D) + NORM_EPS);
#pragma unroll
            for (int hf = 0; hf < 2; ++hf) { const int k0 = hf * 512 + 8 * F.lane;
                f32x4 o0, o1;
#pragma unroll
                for (int j = 0; j < 4; ++j) { o0[j] = v[hf * 8 + j] * rstd * g0[hf][j]; o1[j] = v[hf * 8 + 4 + j] * rstd * g1[hf][j]; }
                *(f32x4*)(F.out + m * D + k0) = o0; *(f32x4*)(F.out + m * D + k0 + 4) = o1; }
        }
    }
}

__device__ __forceinline__ void naive_p1(Frame& F) {
    for (long o = F.gw; o < (long)NTOK * DIN; o += F.NGW) { const int r = (int)(o / DIN), n = (int)(o % DIN);
        const float s = wave_dot_bf16(F.U0 + (size_t)r * D, F.WinT + (size_t)n * D, F.lane); if (F.lane == 0) F.Z[o] = (bf16_t)f2bf(s); }
}
__device__ __forceinline__ void naive_p4(Frame& F) {
    for (long o = F.gw; o < (long)NTOK * D; o += F.NGW) { const int r = (int)(o / D), n = (int)(o % D);
        const float s = wave_dot_bf16(F.MIX + (size_t)r * D, F.WoutT + (size_t)n * D, F.lane); if (F.lane == 0) F.H1[o] = (bf16_t)f2bf(F.in[I_X][o] + s); }
}

__global__ void __launch_bounds__(NTHREADS, 2) mk_fwd(Params p) {
    extern __shared__ __attribute__((aligned(16))) unsigned char lds_raw[];
    Frame F;
    F.lds = (LAS unsigned char*)lds_raw;
    F.tid = threadIdx.x; F.lane = F.tid & 63; F.wave = __builtin_amdgcn_readfirstlane(F.tid >> 6);
    F.G = gridDim.x; { const int bx = blockIdx.x; F.vcu = (F.G % 8 == 0) ? (bx % 8) * (F.G / 8) + bx / 8 : bx; }
    F.gw = F.vcu * NWAVES + F.wave; F.NGW = F.G * NWAVES;
#pragma unroll
    for (int i = 0; i < 24; ++i) F.in[i] = p.in[i];
    F.out = p.out; F.ws = p.ws; unsigned char* ws = p.ws;
    F.ctl = (unsigned*)(ws + WS_CTL);
    F.WinT = (bf16_t*)(ws + WS_WINT); F.WoutT = (bf16_t*)(ws + WS_WOUTT); F.WaT = (bf16_t*)(ws + WS_WAT); F.WxT = (bf16_t*)(ws + WS_WXT);
    F.WR = (float*)(ws + WS_WR); F.UMETA = (bf16_t*)(ws + WS_UMETA); F.ZMETA = (bf16_t*)(ws + WS_ZMETA); F.HMETA = (float*)(ws + WS_HMETA);
    F.SUMM = (float*)(ws + WS_SUMM); F.LIST = (int*)(ws + WS_LIST); F.GATEW = (float*)(ws + WS_GATEW);
    F.WguT = (fp8_t*)(ws + WS_WGUT); F.WdT = (fp8_t*)(ws + WS_WDT); F.U0 = (bf16_t*)(ws + WS_U0); F.Z = (bf16_t*)(ws + WS_Z);
    F.MIX = (bf16_t*)(ws + WS_MIX); F.H1 = (bf16_t*)(ws + WS_H1); F.U1 = (fp8_t*)(ws + WS_U1); F.ACT = (fp8_t*)(ws + WS_ACT); F.Y = (fp8_t*)(ws + WS_Y);

    volatile LAS unsigned* barw = (volatile LAS unsigned*)(F.lds + LDS_BARW);
    if (F.tid < 4) barw[F.tid] = 0u;
    __syncthreads();
    XcdBarrier bar; bar.bar = F.ctl + CW_BAR; bar.x = 0; bar.st = nullptr;
    if (MK_N_LAUNCHES == 1) bar = xcd_barrier_post(F.ctl + CW_BAR, barw);
    const int lo = p.ph_lo, hi = p.ph_hi;
#define IN(k) (((PH_MASK >> (k)) & 1) && lo <= (k) && (k) < hi)
#define SEAM(k) do { if (IN(k) && IN((k) + 1)) xcd_barrier(bar); } while (0)

    if (IN(0)) { p0_prologue(F); }
    SEAM(0);
    if (IN(1)) {
        if (NAIVE_MASK & 2) naive_p1(F);
        else { ProbIn P{F.U0, F.WinT, F.Z, F.G, (int)blockIdx.x}; gemm_phase<ProbIn, false>(F.lds, P); }
        p1_zmeta(F);
    }
    SEAM(1);
    if (IN(2)) {
        for (int it = F.vcu; it < NB * NTILE; it += F.G) {
            if (it < NB * NTILE) {
                const int b = it / NTILE, j = it % NTILE;
#ifndef NO_CONF
                conformer_tile(F, b, j * TT);
                if (DBL_MASK & 1) conformer_tile(F, b, j * TT);
#endif
#ifndef NO_LRU
                float* s = F.SUMM + ((size_t)(b * NTILE + j) * 2) * LW;
                lru_tile<false>(F, b, j * TT, -1000000, -1000000, s, s + LW, it == 0);
                if (DBL_MASK & 2) lru_tile<false>(F, b, j * TT, -1000000, -1000000, s, s + LW);
#endif
            } else {
#ifndef NO_LRU
                lru_tile<false>(F, 0, -TT, -NMETA, -NMETA, F.HMETA + LW, F.HMETA);
                if (DBL_MASK & 4) lru_tile<false>(F, 0, -TT, -NMETA, -NMETA, F.HMETA + LW, F.HMETA);
#endif
            }
        }
    }
    SEAM(2);
    if (IN(3)) {
        for (int it = F.vcu; it < NB * NTILE; it += F.G) {
            const int b = it / NTILE, j = it % NTILE, c = F.tid;
            float hc = F.HMETA[c];
            const size_t row0 = (size_t)b * SEQ + (size_t)j * TT;
            const unsigned* abp = (const unsigned*)(F.ws + WS_AB) + row0 * LW + c;
            const bf16_t* gp = F.Z + ((size_t)b * ZB + ZPAD + (size_t)j * TT) * DIN + 3 * CW + c;
            bf16_t* mp = F.MIX + row0 * D + CW + c;
            unsigned ab[16]; unsigned short gr[16];
#pragma unroll
            for (int i = 0; i < 16; ++i) { ab[i] = abp[(size_t)i * LW]; gr[i] = gp[(size_t)i * DIN]; }
            { const float* sb = F.SUMM + ((size_t)b * NTILE * 2) * LW + c;
              int jj = 0;
              for (; jj + 8 <= j; jj += 8) { float av[8], hv[8];
#pragma unroll
                  for (int u = 0; u < 8; ++u) { av[u] = sb[(size_t)(jj + u) * 2 * LW]; hv[u] = sb[(size_t)(jj + u) * 2 * LW + LW]; }
#pragma unroll
                  for (int u = 0; u < 8; ++u) hc = av[u] * hc + hv[u]; }
              for (; jj < j; ++jj) hc = sb[(size_t)jj * 2 * LW] * hc + sb[(size_t)jj * 2 * LW + LW]; }
#pragma unroll 1
            for (int t0 = 0; t0 < TT; t0 += 16) {
                unsigned nab[16]; unsigned short ngr[16];
                if (t0 + 16 < TT) {
#pragma unroll
                    for (int i = 0; i < 16; ++i) { nab[i] = abp[(size_t)(t0 + 16 + i) * LW]; ngr[i] = gp[(size_t)(t0 + 16 + i) * DIN]; } }
                __builtin_amdgcn_sched_barrier(0);
#pragma unroll
                for (int i = 0; i < 16; ++i) { hc = (1.0f - bflo(ab[i])) * hc + bfhi(ab[i]); mp[(size_t)(t0 + i) * D] = (bf16_t)f2bf(hc * gelu_tanh(bf2f(gr[i]))); }
#pragma unroll
                for (int i = 0; i < 16; ++i) { ab[i] = nab[i]; gr[i] = ngr[i]; }
            }
        }
    }
    SEAM(3);
    if (IN(4)) {
        if (NAIVE_MASK & 16) naive_p4(F);
        else { ProbOut P{F.MIX, F.WoutT, F.in[I_X], F.H1, F.G, (int)blockIdx.x}; gemm_phase<ProbOut, false>(F.lds, P); }
    }
    SEAM(4);
    if (IN(5)) {
        constexpr int NITEM = NE * (D / 64) * (DIN / 64) + NE * (D / 64) * (D / 64);
        const int np = F.G >> 1, pr = F.vcu >> 1, nvw = np * NWAVES, rounds = (NITEM + nvw - 1) / nvw, ks = (rounds * CONV_SPLIT + 12) / 24;
        const bool router = (F.vcu & 1) != 0;
        if (router) {
            int nt = 0; for (int it = pr; it < NTOK / 64; it += np) { p5_route_tile(F, it * 64); ++nt; }
            asm volatile("s_waitcnt vmcnt(0)" ::: "memory"); __syncthreads();
            if (F.tid == 0) (void)xb_add(F.ctl + CW_RDONE, (unsigned)nt);
        }
#pragma unroll 1
        for (int seg = 0; seg < 2; ++seg) {
            const int k_lo = router ? (seg == 0 ? ks : ks + 1) : 0, k_hi = router ? (seg == 0 ? ks + 1 : rounds) : (seg == 0 ? ks : 0);
            expert_weights_to_fp8(F, pr * NWAVES + F.wave, nvw, k_lo, k_hi);
            if (seg == 0 && router) {
                if (F.tid == 0) { XB_SPIN(xb_ld(F.ctl + CW_RDONE) < (unsigned)(NTOK / 64), F.ctl + CW_BAR); __builtin_amdgcn_fence(__ATOMIC_ACQUIRE, "agent"); asm volatile("s_waitcnt vmcnt(0)" ::: "memory"); }
                __syncthreads();
                p5b_lists(F, pr, np);
            }
        }
    }
    SEAM(6);
    if (IN(7)) {
        const MoeSched M = moe_sched_build(F);
        { ProbGU P{F.U1, F.WguT, F.in[I_BGU], F.LIST, F.ACT, M}; gemm_phase<ProbGU, true>(F.lds, P); }
    }
    SEAM(7);
    if (IN(8)) {
        MoeSched M;
        if (MK_N_LAUNCHES == 1 && IN(7)) { LAS int* cnt = (LAS int*)(F.lds + LDS_TAB); M.cnt = cnt; M.tbase = cnt + 64; M.G = F.G; M.vcu = F.vcu; }
        else M = moe_sched_build(F);
        { ProbDown P{F.ACT, F.WdT, F.in[I_BD], F.LIST, (const float*)(F.ws + WS_LISTG), F.Y, M}; gemm_phase<ProbDown, true>(F.lds, P); }
    }
    SEAM(8);
    if (IN(9)) p8_final(F);
#undef IN
#undef SEAM
}
}

extern "C" void kernel_launch(void* const* d_in, const int* in_sizes, int n_in, void* d_out, int out_size, void* d_ws, size_t ws_size, hipStream_t stream) {
    using namespace mk;
    static int grid = 0;
    if (grid == 0) {
        if (n_in != 24 || out_size != NTOK * D || ws_size < WS_END) { fprintf(stderr, "kernel_launch: unexpected shapes (n_in %d out %d ws %zu)\n", n_in, out_size, ws_size); grid = -1; return; }
        int dev = 0, cus = 0, per_cu = 0;
        if (hipGetDevice(&dev) != hipSuccess || hipDeviceGetAttribute(&cus, hipDeviceAttributeMultiprocessorCount, dev) != hipSuccess) { grid = -1; return; }
        if (hipFuncSetAttribute((const void*)mk_fwd, hipFuncAttributeMaxDynamicSharedMemorySize, LDS_BYTES) != hipSuccess) { fprintf(stderr, "kernel_launch: hipFuncSetAttribute failed\n"); grid = -1; return; }
        if (hipOccupancyMaxActiveBlocksPerMultiprocessor(&per_cu, (const void*)mk_fwd, NTHREADS, LDS_BYTES) != hipSuccess || per_cu < 1) { fprintf(stderr, "kernel_launch: occupancy query says %d\n", per_cu); grid = -1; return; }
        grid = cus & ~1;
    }
    if (grid <= 0) return;
    (void)in_sizes;
    (void)hipMemsetAsync((char*)d_ws + WS_CTL, 0, CTL_ZERO_BYTES, stream);
    Params p{};
    for (int i = 0; i < 24; ++i) p.in[i] = (const float*)d_in[i];
    p.out = (float*)d_out; p.ws = (unsigned char*)d_ws;
    if (MK_N_LAUNCHES == 1) { p.ph_lo = 0; p.ph_hi = 10; hipLaunchKernelGGL(mk_fwd, dim3(grid), dim3(NTHREADS), LDS_BYTES, stream, p); }
    else { for (int ph = 0; ph < 10; ++ph) { p.ph_lo = ph; p.ph_hi = ph + 1;
            for (int rep = 0; rep < 1 + ((REP_MASK >> ph) & 1); ++rep) {
                hipLaunchKernelGGL(mk_fwd, dim3(grid), dim3(NTHREADS), LDS_BYTES, stream, p); } } }
}
```
